# Optimizing an MI355X kernel written in HIP

```python
import math
import jax, jax.numpy as jnp
from jax import lax
import numpy as np

D_MODEL = 1024
BATCH = 16
SEQ = 2048
DEPTH = 2

A_HEADS = 8
A_HEAD_DIM = 64
A_WIDTH = A_HEADS * A_HEAD_DIM
IDX_HEADS = 8
IDX_DIM = 64
TOPK_MAX = 256
Q_BLOCK = 128
B_GROUPS = 4
B_GROUP_DIM = 128
B_WIDTH = B_GROUPS * B_GROUP_DIM
CHUNK = 128
REL_BUCKETS = 32
REL_MAX_DIST = 128
N_BRANCH = 2
EPS = 1e-6

SPLIT_SIZES = (A_WIDTH, A_HEAD_DIM, A_HEAD_DIM, A_WIDTH,
               IDX_HEADS * IDX_DIM, IDX_DIM, IDX_HEADS,
               B_WIDTH, B_WIDTH, B_WIDTH,
               D_MODEL, D_MODEL)
N_IN = 5320

kernel_name = "hybrid_dsa_gmlp_gated_parallel"


def rms_norm(x, g):
    xf = x.astype(jnp.float32)
    y = xf * lax.rsqrt(jnp.mean(xf * xf, axis=-1, keepdims=True) + EPS)
    return (y * g.astype(jnp.float32)).astype(x.dtype)


def layer_norm(x, g, b):
    xf = x.astype(jnp.float32)
    mu = jnp.mean(xf, axis=-1, keepdims=True)
    var = jnp.mean(jnp.square(xf - mu), axis=-1, keepdims=True)
    y = (xf - mu) * lax.rsqrt(var + EPS)
    return (y * g.astype(jnp.float32) + b.astype(jnp.float32)).astype(x.dtype)


def split_offsets():
    offs, acc = [], 0
    for s in SPLIT_SIZES[:-1]:
        acc += s
        offs.append(acc)
    return offs


def t5_bucket(rel):
    max_exact = REL_BUCKETS // 2
    is_small = rel < max_exact
    nf = jnp.maximum(rel, 1).astype(jnp.float32)
    large = max_exact + (jnp.log(nf / max_exact) / math.log(REL_MAX_DIST / max_exact)
                         * (REL_BUCKETS - max_exact)).astype(jnp.int32)
    large = jnp.minimum(large, REL_BUCKETS - 1)
    return jnp.where(is_small, rel, large)


def dsa_attention(q, k, v, q_idx, k_idx, w_idx, rel_bias):
    B, S = q.shape[0], q.shape[1]
    k_top = min(TOPK_MAX, S // 4)
    n_blk = S // Q_BLOCK
    scale = A_HEAD_DIM ** -0.5
    key_pos = jnp.arange(S, dtype=jnp.int32)
    w_idx = w_idx * (IDX_HEADS ** -0.5 * IDX_DIM ** -0.5)

    def block(i):
        start = i * Q_BLOCK
        qb = lax.dynamic_slice_in_dim(q, start, Q_BLOCK, axis=1)
        qib = lax.dynamic_slice_in_dim(q_idx, start, Q_BLOCK, axis=1)
        wb = lax.dynamic_slice_in_dim(w_idx, start, Q_BLOCK, axis=1)
        qpos = start + jnp.arange(Q_BLOCK, dtype=jnp.int32)
        sc = jnp.einsum('bqhd,bsd->bqhs', qib, k_idx)
        sc = jnp.einsum('bqhs,bqh->bqs', jax.nn.relu(sc), wb).astype(jnp.float32)
        causal = key_pos[None, :] <= qpos[:, None]
        sc = jnp.where(causal[None], sc, -jnp.inf)
        _, idx = lax.top_k(sc, k_top)
        valid = idx <= qpos[None, :, None]
        k_sel = jax.vmap(lambda kb, ib: kb[ib])(k, idx)
        v_sel = jax.vmap(lambda vb, ib: vb[ib])(v, idx)
        logits = jnp.einsum('bqhd,bqkd->bqhk', qb, k_sel).astype(jnp.float32) * scale
        rel = jnp.maximum(qpos[None, :, None] - idx, 0)
        bias = rel_bias[t5_bucket(rel)]
        logits = logits + jnp.moveaxis(bias, -1, 2).astype(jnp.float32)
        logits = jnp.where(valid[:, :, None, :], logits, -jnp.inf)
        p = jax.nn.softmax(logits, axis=-1).astype(v.dtype)
        return jnp.einsum('bqhk,bqkd->bqhd', p, v_sel)

    out = lax.map(block, jnp.arange(n_blk, dtype=jnp.int32))
    return jnp.moveaxis(out, 0, 1).reshape(B, S, A_WIDTH)


def chunked_sgu(u, v, ln_g, ln_b, w_s, b_s):
    B, S = u.shape[0], u.shape[1]
    v = layer_norm(v, ln_g, ln_b)
    vc = v.reshape(B, S // CHUNK, CHUNK, B_GROUPS, B_GROUP_DIM)
    mask = jnp.tril(jnp.ones((CHUNK, CHUNK), dtype=bool))
    w = jnp.where(mask, w_s, 0)
    s = jnp.einsum('gts,bnsgc->bntgc', w, vc) + b_s.T[None, None, :, :, None]
    return u * s.reshape(B, S, B_WIDTH)


def setup_inputs(seed: int = 0) -> dict:
    key = jax.random.key(seed)
    ks = jax.random.split(key, 16)
    f32 = jnp.float32
    x = jax.random.normal(ks[0], (BATCH, SEQ, D_MODEL), f32)
    norm_g = 1.0 + 0.05 * jax.random.normal(ks[1], (DEPTH, D_MODEL), f32)
    w_in = jax.random.normal(ks[2], (DEPTH, D_MODEL, N_IN), f32) * D_MODEL ** -0.5
    q_norm_g = 1.0 + 0.05 * jax.random.normal(ks[3], (DEPTH, A_HEAD_DIM), f32)
    k_norm_g = 1.0 + 0.05 * jax.random.normal(ks[4], (DEPTH, A_HEAD_DIM), f32)
    rel_bias = 0.5 * jax.random.normal(ks[5], (REL_BUCKETS, A_HEADS), f32)
    sgu_ln_g = 1.0 + 0.05 * jax.random.normal(ks[6], (DEPTH, B_WIDTH), f32)
    sgu_ln_b = 0.02 * jax.random.normal(ks[7], (DEPTH, B_WIDTH), f32)
    w_spatial = jax.random.normal(ks[8], (DEPTH, B_GROUPS, CHUNK, CHUNK), f32) * CHUNK ** -0.5
    b_spatial = 1.0 + 0.1 * jax.random.normal(ks[9], (DEPTH, B_GROUPS, CHUNK), f32)
    w_branch = jax.random.normal(ks[10], (DEPTH, N_BRANCH, A_WIDTH, D_MODEL), f32) * A_WIDTH ** -0.5
    w_out = jax.random.normal(ks[11], (DEPTH, D_MODEL, D_MODEL), f32) * D_MODEL ** -0.5
    return {"x": x, "norm_g": norm_g, "w_in": w_in, "q_norm_g": q_norm_g,
            "k_norm_g": k_norm_g, "rel_bias": rel_bias, "sgu_ln_g": sgu_ln_g,
            "sgu_ln_b": sgu_ln_b, "w_spatial": w_spatial, "b_spatial": b_spatial,
            "w_branch": w_branch, "w_out": w_out}


def reference(x, norm_g, w_in, q_norm_g, k_norm_g, rel_bias, sgu_ln_g, sgu_ln_b,
              w_spatial, b_spatial, w_branch, w_out):
    B, S, _ = x.shape
    offs = split_offsets()
    for l in range(DEPTH):
        h = rms_norm(x, norm_g[l])
        z = jnp.einsum('bsd,dn->bsn', h, w_in[l])
        (q, k, v, gate_a, q_idx, k_idx, w_idx,
         u, v_b, gate_b, merge_a, merge_b) = jnp.split(z, offs, axis=-1)
        q = rms_norm(q.reshape(B, S, A_HEADS, A_HEAD_DIM), q_norm_g[l])
        k = rms_norm(k, k_norm_g[l])
        q_idx = q_idx.reshape(B, S, IDX_HEADS, IDX_DIM)
        y_a = dsa_attention(q, k, v, q_idx, k_idx, w_idx, rel_bias) * jax.nn.silu(gate_a)
        y_b = chunked_sgu(jax.nn.gelu(u), jax.nn.gelu(v_b), sgu_ln_g[l], sgu_ln_b[l],
                          w_spatial[l], b_spatial[l]) * jax.nn.silu(gate_b)
        y = jnp.stack([y_a, y_b], axis=2)
        y_d = jnp.einsum('bsnc,ncd->bsnd', y, w_branch[l])
        merged = jax.nn.sigmoid(merge_a) * y_d[:, :, 0] + jax.nn.sigmoid(merge_b) * y_d[:, :, 1]
        x = x + jnp.einsum('bsd,de->bse', merged, w_out[l])
    return x
```

```cpp
#include <hip/hip_runtime.h>
#include <cstdio>
#include <cstdint>
#include <cmath>
namespace pg8 {
#define PG8_LAS __attribute__((address_space(3)))
typedef unsigned short bf16_t;
typedef short bf16x8 __attribute__((ext_vector_type(8)));
typedef float f32x4 __attribute__((ext_vector_type(4)));
typedef unsigned u32x4 __attribute__((ext_vector_type(4)));
constexpr int BM = 256, BK = 64, HALF = 128, HTB = HALF * BK * 2  , STAGE_BYTES = 8 * HTB, NXCD = 8, WGM = 8;

__host__ __device__ __forceinline__ int lds_byte(int r, int c) { const int st = (r >> 4) * 2 + (c >> 5), rr = r & 15, cc = c & 31, ob = rr * 64 + cc * 2; return st * 1024 + (ob ^ (((ob >> 9) & 1) << 5)); }
__host__ __device__ __forceinline__ void stage_rc(int b, int& R, int& C) { const int st = b / 1024, sb = b % 1024, swz = sb ^ (((sb >> 9) & 1) << 5); R = (st >> 1) * 16 + swz / 64; C = (st & 1) * 32 + (swz % 64) / 2; }
__host__ __device__ __forceinline__ int perm32(int rho) { const int n = rho >> 4, i = rho & 15; return 8 * (i >> 2) + 4 * n + (i & 3); }

struct Unit { int pm, pn; };
struct Gemm { const bf16_t* A; const bf16_t* Bt; int M, N, K; };

struct StaticOrder {
    int nM, nN, nwg, G, c;
    __host__ __device__ void init(int M, int N, int G_, int c_) { nM = M / BM; nN = N / BM; nwg = nM * nN; G = G_; c = c_; }
    __host__ __device__ bool next(int i, Unit& u) const {
        const long L = (long)i * G + c; if (L >= nwg) return false;
        int wgid = (int)L; { const int q = nwg / NXCD, r = nwg % NXCD, xcd = wgid % NXCD, off = wgid / NXCD; wgid = (xcd < r ? xcd * (q + 1) : r * (q + 1) + (xcd - r) * q) + off; }
        const int nig = WGM * nN, gid = wgid / nig, fm = gid * WGM, gsz = (nM - fm) < WGM ? (nM - fm) : WGM;
        u.pm = fm + ((wgid % nig) % gsz); u.pn = (wgid % nig) / gsz; return true;
    }
    __device__ __forceinline__ void a_ready(const Unit&) const {}
    __device__ __forceinline__ void done(const Unit&) const {}
};

__device__ __forceinline__ unsigned cvt_pk_bf16(float lo, float hi) { unsigned r; asm volatile("v_cvt_pk_bf16_f32 %0, %1, %2" : "=v"(r) : "v"(lo), "v"(hi)); return r; }

__device__ __forceinline__ float bf_lo(unsigned w) { return __uint_as_float(w << 16); }
__device__ __forceinline__ float bf_hi(unsigned w) { return __uint_as_float(w & 0xffff0000u); }
__device__ __forceinline__ float fast_sigmoid(float x) { return __builtin_amdgcn_rcpf(1.0f + __builtin_amdgcn_exp2f(-1.4426950408889634f * x)); }
__device__ __forceinline__ u32x4 pack8(const f32x4& a, const f32x4& b) { u32x4 w; w.x = cvt_pk_bf16(a[0], a[1]); w.y = cvt_pk_bf16(a[2], a[3]); w.z = cvt_pk_bf16(b[0], b[1]); w.w = cvt_pk_bf16(b[2], b[3]); return w; }

struct EpiIn {
    static constexpr bool PERM = true, AFTER_DRAIN = false;
    unsigned char* ws; const float *qg, *kg;
    size_t oQ, oKVI, oTB, oWI;
    __device__ __forceinline__ void operator()(const f32x4 (&acc)[2][2][4][2], const Unit& u, int wr, int wc, int fr, int fq) const {
        asm volatile("" : "+v"(fr), "+v"(fq));
        int pn = u.pn; asm volatile("" : "+s"(pn));
        const int row0 = u.pm * BM + wr * 64 + fr;
        if (pn < 2) {
            bf16_t* dst = (bf16_t*)(ws + oQ) + (4 * pn + wc) * 64 + 8 * fq;
#pragma unroll
            for (int ai = 0; ai < 2; ++ai)
#pragma unroll
                for (int m = 0; m < 4; ++m) {
                    const int row = row0 + ai * HALF + m * 16;
                    float ss = 0.f;
#pragma unroll
                    for (int bj = 0; bj < 2; ++bj)
#pragma unroll
                        for (int n = 0; n < 2; ++n) { const f32x4 x = acc[ai][bj][m][n]; ss += (x[0] * x[0] + x[1] * x[1]) + (x[2] * x[2] + x[3] * x[3]); }
                    ss += __shfl_xor(ss, 16); ss += __shfl_xor(ss, 32);
                    const float rs = 1.0f / sqrtf(ss * (1.0f / 64.0f) + 1e-6f);
#pragma unroll
                    for (int bj = 0; bj < 2; ++bj) {
                        const f32x4 v0 = acc[ai][bj][m][0] * rs * *(const f32x4*)(qg + 32 * bj + 8 * fq), v1 = acc[ai][bj][m][1] * rs * *(const f32x4*)(qg + 32 * bj + 8 * fq + 4);
                        *(u32x4*)(dst + (size_t)row * 512 + 32 * bj) = pack8(v0, v1);
                    }
                    asm volatile("" ::: "memory");
                }
        } else if (pn == 2) {
            bf16_t* dst = (bf16_t*)(ws + oKVI + (size_t)wc * (4u << 20)) + 8 * fq;
            float* WI = (float*)(ws + oWI);
#pragma unroll
            for (int ai = 0; ai < 2; ++ai)
#pragma unroll
                for (int m = 0; m < 4; ++m) {
                    const int row = row0 + ai * HALF + m * 16;
                    float ss = 0.f;
#pragma unroll
                    for (int bj = 0; bj < 2; ++bj)
#pragma unroll
                        for (int n = 0; n < 2; ++n) { const f32x4 x = acc[ai][bj][m][n]; ss += (x[0] * x[0] + x[1] * x[1]) + (x[2] * x[2] + x[3] * x[3]); }
                    ss += __shfl_xor(ss, 16); ss += __shfl_xor(ss, 32);
                    const float rs = (wc == 0) ? 1.0f / sqrtf(ss * (1.0f / 64.0f) + 1e-6f) : 1.0f;
                    if (wc == 3) { if (fq == 0) { *(f32x4*)(WI + (size_t)row * 8) = acc[ai][0][m][0]; *(f32x4*)(WI + (size_t)row * 8 + 4) = acc[ai][0][m][1]; } }
                    else {
#pragma unroll
                        for (int bj = 0; bj < 2; ++bj) {
                            f32x4 g0 = *(const f32x4*)(kg + 32 * bj + 8 * fq), g1 = *(const f32x4*)(kg + 32 * bj + 8 * fq + 4);
                            if (wc != 0) { g0 = (f32x4){1.f, 1.f, 1.f, 1.f}; g1 = g0; }
                            const f32x4 v0 = acc[ai][bj][m][0] * rs * g0, v1 = acc[ai][bj][m][1] * rs * g1;
                            *(u32x4*)(dst + (size_t)row * 64 + 32 * bj) = pack8(v0, v1);
                        }
                    }
                    asm volatile("" ::: "memory");
                }
        } else {
            bf16_t* dst = (bf16_t*)(ws + oTB + (size_t)(pn - 3) * (16u << 20)) + 32 * wc + 8 * fq;
            const bool ident = pn < 5, is_gelu = (pn >= 7) && (pn < 11), is_sig = pn >= 13;
            const float a0 = is_gelu ? 1.5957691216f : 1.0f, a1 = is_gelu ? 0.07135481627f : 0.0f;
#pragma unroll
            for (int ai = 0; ai < 2; ++ai)
#pragma unroll
                for (int m = 0; m < 4; ++m) {
                    const int row = row0 + ai * HALF + m * 16;
#pragma unroll
                    for (int bj = 0; bj < 2; ++bj) {
                        f32x4 v0 = acc[ai][bj][m][0], v1 = acc[ai][bj][m][1];
                        if (!ident) {
#pragma unroll
                            for (int i = 0; i < 4; ++i) {
                                float x = v0[i]; float t = fast_sigmoid(x * (a0 + a1 * x * x)); v0[i] = is_sig ? t : x * t;
                                x = v1[i]; t = fast_sigmoid(x * (a0 + a1 * x * x)); v1[i] = is_sig ? t : x * t;
                            }
                        }
                        *(u32x4*)(dst + (size_t)row * 256 + 128 * bj) = pack8(v0, v1);
                    }
                    asm volatile("" ::: "memory");
                }
        }
    }
};

struct EpiBrA {
    static constexpr bool PERM = true, AFTER_DRAIN = false;
    const bf16_t* G; bf16_t* T;
    __device__ __forceinline__ void operator()(const f32x4 (&acc)[2][2][4][2], const Unit& u, int wr, int wc, int fr, int fq) const {
        asm volatile("" : "+v"(fr), "+v"(fq));
        const int row0 = u.pm * BM + wr * 64 + fr, colw = u.pn * BM + 32 * wc + 8 * fq;
#pragma unroll
        for (int ai = 0; ai < 2; ++ai)
#pragma unroll
            for (int m = 0; m < 4; ++m) {
                const size_t ro = (size_t)(row0 + ai * HALF + m * 16) * 1024 + colw;
#pragma unroll
                for (int bj = 0; bj < 2; ++bj) {
                    const u32x4 gw = *(const u32x4*)(G + (size_t)u.pn * ((size_t)8 << 20) + (size_t)(row0 + ai * HALF + m * 16) * 256 + (32 * wc + 8 * fq) + 128 * bj);
                    f32x4 v0 = acc[ai][bj][m][0], v1 = acc[ai][bj][m][1];
                    v0[0] *= bf_lo(gw.x); v0[1] *= bf_hi(gw.x); v0[2] *= bf_lo(gw.y); v0[3] *= bf_hi(gw.y);
                    v1[0] *= bf_lo(gw.z); v1[1] *= bf_hi(gw.z); v1[2] *= bf_lo(gw.w); v1[3] *= bf_hi(gw.w);
                    *(u32x4*)(T + ro + 128 * bj) = pack8(v0, v1);
                }
                asm volatile("" ::: "memory");
            }
    }
};
struct EpiBrB {
    static constexpr bool PERM = true, AFTER_DRAIN = false;
    const bf16_t* G; bf16_t* T;
    __device__ __forceinline__ void operator()(const f32x4 (&acc)[2][2][4][2], const Unit& u, int wr, int wc, int fr, int fq) const {
        asm volatile("" : "+v"(fr), "+v"(fq));
        const int row0 = u.pm * BM + wr * 64 + fr, colw = u.pn * BM + 32 * wc + 8 * fq;
#pragma unroll
        for (int ai = 0; ai < 2; ++ai)
#pragma unroll
            for (int m = 0; m < 4; ++m) {
                const size_t ro = (size_t)(row0 + ai * HALF + m * 16) * 1024 + colw;
#pragma unroll
                for (int bj = 0; bj < 2; ++bj) {
                    const u32x4 gw = *(const u32x4*)(G + (size_t)u.pn * ((size_t)8 << 20) + (size_t)(row0 + ai * HALF + m * 16) * 256 + (32 * wc + 8 * fq) + 128 * bj);
                    const u32x4 tw = *(const u32x4*)(T + ro + 128 * bj);
                    f32x4 v0 = acc[ai][bj][m][0], v1 = acc[ai][bj][m][1];
                    v0[0] = v0[0] * bf_lo(gw.x) + bf_lo(tw.x); v0[1] = v0[1] * bf_hi(gw.x) + bf_hi(tw.x); v0[2] = v0[2] * bf_lo(gw.y) + bf_lo(tw.y); v0[3] = v0[3] * bf_hi(gw.y) + bf_hi(tw.y);
                    v1[0] = v1[0] * bf_lo(gw.z) + bf_lo(tw.z); v1[1] = v1[1] * bf_hi(gw.z) + bf_hi(tw.z); v1[2] = v1[2] * bf_lo(gw.w) + bf_lo(tw.w); v1[3] = v1[3] * bf_hi(gw.w) + bf_hi(tw.w);
                    *(u32x4*)(T + ro + 128 * bj) = pack8(v0, v1);
                }
                asm volatile("" ::: "memory");
            }
    }
};
struct EpiOut {
    static constexpr bool PERM = false, AFTER_DRAIN = false;
    const float* base; float* out;
    __device__ __forceinline__ void operator()(const f32x4 (&acc)[2][2][4][2], const Unit& u, int wr, int wc, int fr, int fq) const {
        asm volatile("" : "+v"(fr), "+v"(fq));
        const int row0 = u.pm * BM + wr * 64 + fr, col0 = u.pn * BM + wc * 32 + 4 * fq;
#pragma unroll
        for (int ai = 0; ai < 2; ++ai)
#pragma unroll
            for (int m = 0; m < 4; ++m) {
                const size_t ro = (size_t)(row0 + ai * HALF + m * 16) * 1024 + col0;
#pragma unroll
                for (int bj = 0; bj < 2; ++bj)
#pragma unroll
                    for (int n = 0; n < 2; ++n) { const f32x4 b = *(const f32x4*)(base + ro + bj * HALF + n * 16); *(f32x4*)(out + ro + bj * HALF + n * 16) = b + acc[ai][bj][m][n]; }
            }
    }
};
template <class Epi, class Sched, bool ALIGN_EPI = false, bool SP2 = false>
__device__ __forceinline__ void gemm_phase(PG8_LAS unsigned char* lds, const Gemm g, const Sched& S, const Epi& E) {
    int tid = threadIdx.x; asm volatile("" : "+v"(tid));
    const int wid = __builtin_amdgcn_readfirstlane(tid >> 6), lane = tid & 63, wr = wid >> 2, wc = wid & 3, fr = lane & 15, fq = lane >> 4;
    const int K = g.K, nt = K / BK;
    unsigned voffA[2], voffB[2];
#pragma unroll
    for (int i = 0; i < 2; ++i) { int R, C; stage_rc(tid * 16 + i * 8192, R, C); const int Rb = Epi::PERM ? ((R & ~31) + perm32(R & 31)) : R;
        voffA[i] = (unsigned)(R * K + C) * 2u; voffB[i] = (unsigned)(Rb * K + C) * 2u; }
    const size_t kstep = (size_t)(BK * 2);
    const size_t hstep = (size_t)HALF * K * 2;
    const size_t tstep = 2 * hstep;
    const unsigned ldsw = (unsigned)wid * 1024u;
    const int aoff = lds_byte(wr * 64 + fr, fq * 8), boff = lds_byte(wc * 32 + fr, fq * 8);
#define PG8_SA(b, h) (((b) * 2 + (h)) * HTB)
#define PG8_SB(b, h) ((4 + (b) * 2 + (h)) * HTB)
#define PG8_STAGE(bufoff, gbase, voff) do { _Pragma("unroll") for (int _i = 0; _i < 2; ++_i) \
        __builtin_amdgcn_global_load_lds((const unsigned*)((const char*)(gbase) + (voff)[_i]), (PG8_LAS unsigned*)(lds + (bufoff) + ldsw + _i * 8192), 16, 0, 0); } while (0)
#define PG8_LDA(dst, b, h) do { _Pragma("unroll") for (int m = 0; m < 4; ++m) _Pragma("unroll") for (int k = 0; k < 2; ++k) dst[m][k] = *(const PG8_LAS bf16x8*)(lds + PG8_SA(b, h) + aoff + m * 2048 + k * 1024); } while (0)
#define PG8_LDB(dst, b, h) do { _Pragma("unroll") for (int n = 0; n < 2; ++n) _Pragma("unroll") for (int k = 0; k < 2; ++k) dst[n][k] = *(const PG8_LAS bf16x8*)(lds + PG8_SB(b, h) + boff + n * 2048 + k * 1024); } while (0)
#define PG8_MMA(ai, bj, At, Bt) do { __builtin_amdgcn_s_setprio(1); _Pragma("unroll") for (int m = 0; m < 4; ++m) _Pragma("unroll") for (int n = 0; n < 2; ++n) _Pragma("unroll") for (int k = 0; k < 2; ++k) \
        acc[ai][bj][m][n] = __builtin_amdgcn_mfma_f32_16x16x32_bf16(Bt[n][k], At[m][k], acc[ai][bj][m][n], 0, 0, 0); __builtin_amdgcn_s_setprio(0); } while (0)
#define PG8_WAIT_V(n) asm volatile("s_waitcnt vmcnt(" #n ")" ::: "memory")
#define PG8_WAIT_L(n) asm volatile("s_waitcnt lgkmcnt(" #n ")" ::: "memory")
#define PG8_BAR __builtin_amdgcn_s_barrier()
#define PG8_SCHED __builtin_amdgcn_sched_barrier(0)
    Unit cur, nxt; int ui = 0;
    if (!S.next(0, cur)) return;
    f32x4 acc[2][2][4][2];
#pragma unroll
    for (int a = 0; a < 2; ++a)
#pragma unroll
        for (int b = 0; b < 2; ++b)
#pragma unroll
            for (int m = 0; m < 4; ++m)
#pragma unroll
                for (int n = 0; n < 2; ++n) acc[a][b][m][n] = (f32x4){0.f, 0.f, 0.f, 0.f};
    bf16x8 At[4][2], B0[2][2], B1[2][2];
    const char* cA = (const char*)g.A + (size_t)cur.pm * tstep; const char* cB = (const char*)g.Bt + (size_t)cur.pn * tstep;
    S.a_ready(cur);
    if constexpr (SP2) {
        PG8_STAGE(PG8_SB(0, 0), cB, voffB); PG8_STAGE(PG8_SB(0, 1), cB + hstep, voffB); PG8_STAGE(PG8_SA(0, 0), cA, voffA); PG8_STAGE(PG8_SA(0, 1), cA + hstep, voffA);
        if (wr == 1) PG8_BAR;
        PG8_WAIT_V(2); PG8_BAR;
        PG8_STAGE(PG8_SB(1, 0), cB + kstep, voffB); PG8_STAGE(PG8_SA(1, 0), cA + kstep, voffA); PG8_STAGE(PG8_SB(1, 1), cB + hstep + kstep, voffB);
        PG8_WAIT_V(6); PG8_BAR;
    } else {
        PG8_STAGE(PG8_SB(0, 0), cB, voffB); PG8_STAGE(PG8_SA(0, 0), cA, voffA); PG8_STAGE(PG8_SB(0, 1), cB + hstep, voffB); PG8_STAGE(PG8_SA(0, 1), cA + hstep, voffA);
        if (wr == 1) PG8_BAR;
        PG8_WAIT_V(4); PG8_BAR;
        PG8_STAGE(PG8_SB(1, 0), cB + kstep, voffB); PG8_STAGE(PG8_SA(1, 0), cA + kstep, voffA); PG8_STAGE(PG8_SB(1, 1), cB + hstep + kstep, voffB);
        PG8_WAIT_V(6); PG8_BAR;
    }
    for (;;) {
        const bool has_next = S.next(ui + 1, nxt);
        const char* nA = has_next ? (const char*)g.A + (size_t)nxt.pm * tstep : cA; const char* nB = has_next ? (const char*)g.Bt + (size_t)nxt.pn * tstep : cB;
        for (int t = 0; t < nt; t += 2) {
            const bool last = (t == nt - 2);
            const char* a1 = cA + (size_t)(t + 1) * kstep;
            const char* a2 = last ? nA : cA + (size_t)(t + 2) * kstep; const char* b2 = last ? nB : cB + (size_t)(t + 2) * kstep;
            const char* a3 = a2 + kstep; const char* b3 = b2 + kstep;
            if (last && has_next) S.a_ready(nxt);
            if constexpr (SP2) {
            PG8_LDB(B0, 0, 0); PG8_LDB(B1, 0, 1); PG8_SCHED; PG8_LDA(At, 0, 0); PG8_STAGE(PG8_SA(1, 1), a1 + hstep, voffA);
            PG8_WAIT_V(8); PG8_WAIT_L(0); PG8_BAR; PG8_MMA(0, 0, At, B0); PG8_MMA(0, 1, At, B1); PG8_BAR; PG8_SCHED;
            PG8_LDA(At, 0, 1); PG8_STAGE(PG8_SB(0, 0), b2, voffB); PG8_STAGE(PG8_SB(0, 1), b2 + hstep, voffB); PG8_STAGE(PG8_SA(0, 0), a2, voffA);
            PG8_WAIT_V(8); PG8_WAIT_L(0); PG8_BAR; PG8_MMA(1, 0, At, B0); PG8_MMA(1, 1, At, B1); PG8_BAR; PG8_SCHED;
            PG8_LDB(B0, 1, 0); PG8_LDB(B1, 1, 1); PG8_SCHED; PG8_LDA(At, 1, 0); PG8_STAGE(PG8_SA(0, 1), a2 + hstep, voffA);
            PG8_WAIT_V(8); PG8_WAIT_L(0); PG8_BAR; PG8_MMA(0, 0, At, B0); PG8_MMA(0, 1, At, B1); PG8_BAR; PG8_SCHED;
            PG8_LDA(At, 1, 1); PG8_STAGE(PG8_SB(1, 0), b3, voffB); PG8_STAGE(PG8_SB(1, 1), b3 + hstep, voffB); PG8_STAGE(PG8_SA(1, 0), a3, voffA);
            PG8_WAIT_V(8); PG8_WAIT_L(0); PG8_BAR; PG8_MMA(1, 0, At, B0); PG8_MMA(1, 1, At, B1); PG8_BAR; PG8_SCHED;
            } else {
            PG8_LDB(B0, 0, 0); PG8_SCHED; PG8_LDA(At, 0, 0); PG8_STAGE(PG8_SA(1, 1), a1 + hstep, voffA);
            PG8_WAIT_L(8); PG8_BAR; PG8_WAIT_L(0); PG8_MMA(0, 0, At, B0); PG8_BAR; PG8_SCHED;
            PG8_LDB(B1, 0, 1); PG8_STAGE(PG8_SB(0, 0), b2, voffB);
            PG8_BAR; PG8_WAIT_L(0); PG8_MMA(0, 1, At, B1); PG8_BAR;
            PG8_LDA(At, 0, 1); PG8_STAGE(PG8_SA(0, 0), a2, voffA);
            PG8_BAR; PG8_WAIT_L(0); PG8_MMA(1, 0, At, B0); PG8_BAR; PG8_SCHED;
            PG8_STAGE(PG8_SB(0, 1), b2 + hstep, voffB);
            PG8_WAIT_V(6); PG8_BAR; PG8_MMA(1, 1, At, B1); PG8_BAR;
            PG8_LDB(B0, 1, 0); PG8_SCHED; PG8_LDA(At, 1, 0); PG8_STAGE(PG8_SA(0, 1), a2 + hstep, voffA);
            PG8_WAIT_L(8); PG8_BAR; PG8_WAIT_L(0); PG8_MMA(0, 0, At, B0); PG8_BAR; PG8_SCHED;
            PG8_LDB(B1, 1, 1); PG8_STAGE(PG8_SB(1, 0), b3, voffB);
            PG8_BAR; PG8_WAIT_L(0); PG8_MMA(0, 1, At, B1); PG8_BAR;
            PG8_LDA(At, 1, 1); PG8_STAGE(PG8_SA(1, 0), a3, voffA);
            PG8_BAR; PG8_WAIT_L(0); PG8_MMA(1, 0, At, B0); PG8_BAR; PG8_SCHED;
            PG8_STAGE(PG8_SB(1, 1), b3 + hstep, voffB);
            PG8_WAIT_V(6); PG8_BAR; PG8_MMA(1, 1, At, B1); PG8_BAR;
            }
        }
        if constexpr (ALIGN_EPI) { if (wr == 0) PG8_BAR; }
        if constexpr (!Epi::AFTER_DRAIN) { E(acc, cur, wr, wc, fr, fq); S.done(cur); }
        if (!has_next) break;
#pragma unroll
        for (int a = 0; a < 2; ++a)
#pragma unroll
            for (int b = 0; b < 2; ++b)
#pragma unroll
                for (int m = 0; m < 4; ++m)
#pragma unroll
                    for (int n = 0; n < 2; ++n) acc[a][b][m][n] = (f32x4){0.f, 0.f, 0.f, 0.f};
        cur = nxt; cA = nA; cB = nB; ++ui;
        if constexpr (ALIGN_EPI) { if (wr == 1) PG8_BAR; }
    }
    PG8_WAIT_V(0);
    if constexpr (!ALIGN_EPI) { if (wr == 0) PG8_BAR; }
    PG8_BAR;
    if constexpr (Epi::AFTER_DRAIN) { E.fused(acc, cur, wr, wc, fr, fq, lds, wid, lane); S.done(cur); }
#undef PG8_SA
#undef PG8_SB
#undef PG8_STAGE
#undef PG8_LDA
#undef PG8_LDB
#undef PG8_MMA
#undef PG8_WAIT_V
#undef PG8_WAIT_L
#undef PG8_BAR
#undef PG8_SCHED
}
}
#define GAS __attribute__((address_space(1)))
#define LAS __attribute__((address_space(3)))
typedef unsigned short bf16;
typedef unsigned v4u __attribute__((ext_vector_type(4)));
typedef float f32x4 __attribute__((ext_vector_type(4)));
typedef short bf16x8 __attribute__((ext_vector_type(8)));
typedef GAS unsigned gu32;
typedef GAS unsigned long long gu64;
#define RLX_AGENT __ATOMIC_RELAXED, __HIP_MEMORY_SCOPE_AGENT
#define LDS_WAIT() asm volatile("s_waitcnt lgkmcnt(0)" ::: "memory")
#define VM_WAIT() asm volatile("s_waitcnt vmcnt(0)" ::: "memory")
__device__ __forceinline__ unsigned long long rt() { return __builtin_amdgcn_s_memrealtime(); }
__device__ __forceinline__ unsigned f2bf(float f) { unsigned u = __builtin_bit_cast(unsigned, f); return (u + 0x7fffu + ((u >> 16) & 1u)) >> 16; }
__device__ __forceinline__ unsigned pk2(float lo, float hi) { return f2bf(lo) | (f2bf(hi) << 16); }

#define XB_TMO      128
#define XB_XCNT(j)  (256  + 64 * (j))
#define XB_XSUB(j)  (1280 + 64 * (j))
#define XB_XGEN(j)  (2304 + 64 * (j))
#define XB_TOP      3328
#define XB_TOPGEN   3392
#define XCD_BAR_WORDS 3456
#define XB_SPIN_CAP (1u << 18)

__device__ __forceinline__ unsigned xb_ld(unsigned* p)              { return __hip_atomic_load(p, __ATOMIC_RELAXED, __HIP_MEMORY_SCOPE_AGENT); }
__device__ __forceinline__ unsigned xb_add(unsigned* p, unsigned v) { return __hip_atomic_fetch_add(p, v, __ATOMIC_RELAXED, __HIP_MEMORY_SCOPE_AGENT); }
__device__ __forceinline__ unsigned xb_xcc_id() { return (unsigned)__builtin_amdgcn_s_getreg((3 << 11) | 20) & 0xFu; }
#define XB_SPIN(cond, bar) do { unsigned _sp = 0; while (cond) { __builtin_amdgcn_s_sleep(1); \
    if ((++_sp & 255u) == 0u) { if (xb_ld(&(bar)[XB_TMO])) break; if (_sp > XB_SPIN_CAP) { atomicAdd(&(bar)[XB_TMO], 1u); break; } } } } while (0)

struct XcdBarrier {
    unsigned* bar; unsigned x;
    volatile LAS unsigned* st;
};

__device__ __forceinline__ XcdBarrier xcd_barrier_post(unsigned* bar, volatile LAS unsigned* st) {
    XcdBarrier b; b.bar = bar; b.x = xb_xcc_id(); b.st = st;
    if (threadIdx.x == 0) (void)xb_add(&bar[XB_XCNT(b.x)], 1u);
    return b;
}
__device__ __forceinline__ void xcd_barrier_complete(unsigned* bar, unsigned x, unsigned& nloc, unsigned& nx) {
    const unsigned G = gridDim.x * gridDim.y * gridDim.z;
    unsigned sum, cnt, mine, sp = 0u;
    for (;;) {
        sum = 0u; cnt = 0u; mine = 0u;
#pragma unroll
        for (unsigned j = 0; j < 16; ++j) { const unsigned c = xb_ld(&bar[XB_XCNT(j)]); sum += c; cnt += (c > 0u) ? 1u : 0u; mine = (j == x) ? c : mine; }
        if (sum == G) break;
        __builtin_amdgcn_s_sleep(1);
        if ((++sp & 255u) == 0u) { if (xb_ld(&bar[XB_TMO])) break; if (sp > XB_SPIN_CAP) { atomicAdd(&bar[XB_TMO], 1u); break; } }
    }
    nloc = mine > 0u ? mine : 1u; nx = cnt > 0u ? cnt : 1u;
}

__device__ __forceinline__ void xcd_barrier(const XcdBarrier& b) {
    asm volatile("s_waitcnt vmcnt(0)" ::: "memory");
    __syncthreads();
    if (threadIdx.x == 0) {
        unsigned* bar = b.bar;
        __builtin_amdgcn_s_waitcnt(0);
        unsigned nloc = b.st[0], nx = b.st[1];
        if (nloc == 0u) { xcd_barrier_complete(bar, b.x, nloc, nx); b.st[0] = nloc; b.st[1] = nx; }
        const unsigned old = xb_add(&bar[XB_XSUB(b.x)], 1u);
        const unsigned gen = old / nloc;
        if (old + 1u == (gen + 1u) * nloc) {
            __builtin_amdgcn_fence(__ATOMIC_RELEASE, "agent");
            asm volatile("s_waitcnt vmcnt(0)" ::: "memory");
            const unsigned og = xb_add(&bar[XB_TOP], 1u);
            const unsigned tg = og / nx;
            if (og + 1u == (tg + 1u) * nx) xb_add(&bar[XB_TOPGEN], 1u);
            else XB_SPIN(xb_ld(&bar[XB_TOPGEN]) == tg, bar);
            __builtin_amdgcn_fence(__ATOMIC_ACQUIRE, "agent");
            xb_add(&bar[XB_XGEN(b.x)], 1u);
            asm volatile("s_waitcnt vmcnt(0)" ::: "memory");
        } else {
            XB_SPIN(xb_ld(&bar[XB_XGEN(b.x)]) == gen, bar);
            __builtin_amdgcn_fence(__ATOMIC_ACQUIRE, "agent");
            asm volatile("s_waitcnt vmcnt(0)" ::: "memory");
        }
    }
    __syncthreads();
}


constexpr int NWAVES = 8;
constexpr int BATCH = 16, SEQ = 2048, DM = 1024, M = BATCH * SEQ;
constexpr int NIN_SRC = 5320, NIN = 5376;
constexpr float EPS = 1e-6f;
constexpr float LOG2E = 1.4426950408889634f;

constexpr size_t MiB = 1u << 20;
constexpr size_t WS_CTL = 0, CTL_ZERO_BYTES = 1 * MiB;
constexpr size_t WS_WIN = 2 * MiB;
constexpr size_t WIN_LAYER = (size_t)NIN * DM * 2;
constexpr size_t WS_WBR = 23 * MiB;
constexpr size_t WS_WOUT = 27 * MiB;
constexpr size_t WS_WSP = 31 * MiB;
constexpr size_t WS_XN = 32 * MiB;
constexpr size_t WS_YA = 32 * MiB, WS_YB = 64 * MiB;
constexpr size_t WS_Q = 96 * MiB, WS_QI = 128 * MiB;
constexpr size_t WS_T = 96 * MiB;
constexpr size_t WS_GA = 160 * MiB, WS_U = 192 * MiB, WS_VB = 224 * MiB, WS_GB = 256 * MiB;
constexpr size_t WS_MA = 288 * MiB, WS_MB = 352 * MiB;
constexpr size_t WS_K = 416 * MiB, WS_V = 420 * MiB, WS_KI = 424 * MiB, WS_WI = 428 * MiB;
constexpr size_t WS_END = 429 * MiB;
constexpr size_t TILE_ELEMS = (size_t)M * 256;
constexpr int CW_BAR = 4096;

constexpr int RING_OFF = 0, RING_BYTES = 131072;
constexpr int LDSCTL_OFF = RING_BYTES, MISC_OFF = LDSCTL_OFF + 320;
constexpr int LDS_BYTES = 147456;
constexpr int L_BKT = 0, L_BIASB = 2048, L_MFIX = 3072, L_STAT = 4096, L_VNT = 5120, L_ATT = 40960, ATT_WAVE_BYTES = 7168;
constexpr int VNT_LD = 136;
constexpr int VS_LD = 80;

typedef float f32x16 __attribute__((ext_vector_type(16)));
typedef short s16x4 __attribute__((ext_vector_type(4)));
typedef unsigned u32x2 __attribute__((ext_vector_type(2)));
typedef unsigned u32x4 __attribute__((ext_vector_type(4)));

__device__ __forceinline__ float bf2f(bf16 v) { return __uint_as_float((unsigned)v << 16); }
__device__ __forceinline__ float wave_sum(float v) {
#pragma unroll
    for (int o = 1; o < 64; o <<= 1) v += __shfl_xor(v, o);
    return v;
}
__device__ __forceinline__ float wave_max(float v) {
#pragma unroll
    for (int o = 1; o < 64; o <<= 1) v = fmaxf(v, __shfl_xor(v, o));
    return v;
}

__device__ __forceinline__ void p0_tr_item(const float* W, int ldw, int src_col0, int nvalid, int k0, bf16* WT, int Kd, int dst_row0, LAS float* scr, int lane) {
    const int n = lane & 31;
#pragma unroll 8
    for (int i = 0; i < 32; ++i) { const int kk = 2 * i + (lane >> 5); scr[kk * 33 + n] = (n < nvalid) ? W[(size_t)(k0 + kk) * ldw + src_col0 + n] : 0.f; }
    LDS_WAIT(); asm volatile("" ::: "memory");
    const int c = lane & 7;
#pragma unroll
    for (int j = 0; j < 4; ++j) { const int nn = (lane >> 3) + 8 * j; const LAS float* s = scr + (8 * c) * 33 + nn;
        v4u o; o.x = pk2(s[0 * 33], s[1 * 33]); o.y = pk2(s[2 * 33], s[3 * 33]); o.z = pk2(s[4 * 33], s[5 * 33]); o.w = pk2(s[6 * 33], s[7 * 33]);
        *(GAS v4u*)(WT + (size_t)(dst_row0 + nn) * Kd + k0 + 8 * c) = o; }
    LDS_WAIT(); asm volatile("" ::: "memory");
}
__device__ __forceinline__ void win_block_src(int vb, int& src, int& nvalid) {
    const int tile = vb >> 3, j = vb & 7; nvalid = 32;
    if (tile < 2) { const int hh = j & 3, dhi = j >> 2; src = (4 * tile + hh) * 64 + 32 * dhi; }
    else if (tile == 2) { const int hh = j & 3, dhi = j >> 2;
        if (hh == 0) src = 512 + 32 * dhi; else if (hh == 1) src = 576 + 32 * dhi; else if (hh == 2) src = 1664 + 32 * dhi; else { src = 1728; nvalid = (dhi == 0) ? 8 : 0; } }
    else { const int v = vb * 32;
        if (v < 1280) src = 1152 + (v - 768); else if (v < 1792) src = 640 + (v - 1280); else if (v < 2304) src = 1736 + (v - 1792); else if (v < 2816) src = 2248 + (v - 2304);
        else if (v < 3328) src = 2760 + (v - 2816); else if (v < 4352) src = 3272 + (v - 3328); else src = 4296 + (v - 4352); }
}
__device__ __forceinline__ void rms_row_to_bf16(const float* xrow, const float* g, bf16* orow, int lane) {
    const GAS f32x4* xr = (const GAS f32x4*)xrow + lane; const f32x4* gr = (const f32x4*)g + lane;
    f32x4 v[4]; float s = 0.f;
#pragma unroll
    for (int j = 0; j < 4; ++j) { v[j] = xr[64 * j]; s += (v[j].x * v[j].x + v[j].y * v[j].y) + (v[j].z * v[j].z + v[j].w * v[j].w); }
    const float rs = 1.0f / sqrtf(wave_sum(s) * (1.0f / DM) + EPS);
    GAS unsigned long long* o8 = (GAS unsigned long long*)orow + lane;
#pragma unroll
    for (int j = 0; j < 4; ++j) { const f32x4 gg = gr[64 * j]; const f32x4 o = v[j] * rs * gg;
        o8[64 * j] = (unsigned long long)pk2(o.x, o.y) | ((unsigned long long)pk2(o.z, o.w) << 32); }
}

struct Frame {
    LAS unsigned char* lds;
    int tid, lane, wave, vcu, G;
    const float *x, *norm_g, *w_in, *q_norm_g, *k_norm_g, *rel_bias, *sgu_ln_g, *sgu_ln_b, *w_spatial, *b_spatial, *w_branch, *w_out;
    float* out; unsigned char* ws;
};

__device__ __forceinline__ void p0_prologue(Frame& F0) {
    Frame F = F0; { int t = F.tid; asm volatile("" : "+v"(t)); F.tid = t; F.lane = t & 63; }
    LAS float* scr = (LAS float*)(F.lds + RING_OFF + F.wave * 16384);
    const int gw = F.vcu * NWAVES + F.wave, NGW = F.G * NWAVES;
    constexpr int I_IN = (NIN / 32) * (DM / 64);
    constexpr int I_BR = (DM / 32) * (512 / 64);
    constexpr int I_OUT = (DM / 32) * (DM / 64);
    constexpr int I_LAYER = I_IN + 2 * I_BR + I_OUT;
    for (int it = gw; it < 2 * I_LAYER; it += NGW) {
        const int l = it / I_LAYER; int r = it % I_LAYER;
        if (r < I_IN) { const int vb = r / (DM / 64), kb = r % (DM / 64); int src, nv; win_block_src(vb, src, nv);
            p0_tr_item(F.w_in + (size_t)l * DM * NIN_SRC, NIN_SRC, src, nv, 64 * kb, (bf16*)(F.ws + WS_WIN + l * WIN_LAYER), DM, 32 * vb, scr, F.lane); continue; }
        r -= I_IN;
        if (r < 2 * I_BR) { const int br = r / I_BR, q = r % I_BR, nb = q / 8, kb = q % 8;
            p0_tr_item(F.w_branch + (size_t)(l * 2 + br) * 512 * DM, DM, 32 * nb, 32, 64 * kb, (bf16*)(F.ws + WS_WBR + (size_t)(l * 2 + br) * MiB), 512, 32 * nb, scr, F.lane); continue; }
        r -= 2 * I_BR;
        { const int nb = r / 16, kb = r % 16;
            p0_tr_item(F.w_out + (size_t)l * DM * DM, DM, 32 * nb, 32, 64 * kb, (bf16*)(F.ws + WS_WOUT + (size_t)l * 2 * MiB), DM, 32 * nb, scr, F.lane); }
    }
    { bf16* wsp = (bf16*)(F.ws + WS_WSP);
      for (int i = (F.vcu * NWAVES * 64) + F.tid; i < 2 * 4 * 128 * 128; i += F.G * NWAVES * 64) { const int s = i & 127, t = (i >> 7) & 127; wsp[i] = (s <= t) ? (bf16)f2bf(F.w_spatial[i]) : (bf16)0; } }
    for (int m = gw; m < M; m += NGW) rms_row_to_bf16(F.x + (size_t)m * DM, F.norm_g, (bf16*)(F.ws + WS_XN) + (size_t)m * DM, F.lane);
}
__device__ __forceinline__ void p5_renorm(Frame& F0, const float* xin, const float* g) {
    Frame F = F0; { int t = F.tid; asm volatile("" : "+v"(t)); F.tid = t; F.lane = t & 63; }
    const int gw = F.vcu * NWAVES + F.wave, NGW = F.G * NWAVES;
    for (int m = gw; m < M; m += NGW) rms_row_to_bf16(xin + (size_t)m * DM, g, (bf16*)(F.ws + WS_XN) + (size_t)m * DM, F.lane);
}

__device__ __forceinline__ void sgu_chunk(Frame& F, int r0, const bf16* VB, const bf16* U, const bf16* GB, const bf16* WsB, const float* bsp, const float* lng, const float* lnb, bf16* YB) {
    typedef float f32x2v __attribute__((ext_vector_type(2)));
    LAS f32x2v* stat = (LAS f32x2v*)(F.lds + L_STAT);
    LAS bf16* vnT = (LAS bf16*)(F.lds + L_VNT);
    const int tid = F.tid, lane = F.lane;
    {
        const int row = tid >> 2, q4 = tid & 3;
        const v4u* p = (const v4u*)(VB + (size_t)(q4 >> 1) * TILE_ELEMS + (size_t)(r0 + row) * 256 + (q4 & 1) * 128);
        float s = 0.f, ss = 0.f;
#pragma unroll 4
        for (int i = 0; i < 16; ++i) { const v4u w = p[i];
            const float e0 = pg8::bf_lo(w.x), e1 = pg8::bf_hi(w.x), e2 = pg8::bf_lo(w.y), e3 = pg8::bf_hi(w.y), e4 = pg8::bf_lo(w.z), e5 = pg8::bf_hi(w.z), e6 = pg8::bf_lo(w.w), e7 = pg8::bf_hi(w.w);
            s += ((e0 + e1) + (e2 + e3)) + ((e4 + e5) + (e6 + e7));
            ss += ((e0 * e0 + e1 * e1) + (e2 * e2 + e3 * e3)) + ((e4 * e4 + e5 * e5) + (e6 * e6 + e7 * e7)); }
        s += __shfl_xor(s, 1); ss += __shfl_xor(ss, 1); s += __shfl_xor(s, 2); ss += __shfl_xor(ss, 2);
        const float mean = s * (1.0f / 512.0f); float var = ss * (1.0f / 512.0f) - mean * mean; var = var < 0.f ? 0.f : var;
        if (q4 == 0) stat[row] = (f32x2v){mean, 1.0f / sqrtf(var + EPS)};
    }
    __syncthreads();
    const int wv = F.wave, tt = wv >> 1, ch = wv & 1, hh = lane >> 5, cl = lane & 31;
    for (int g = 0; g < 4; ++g) {
        {
            const int sp = tid >> 2, cs = (tid & 3) * 32; const f32x2v st = stat[sp];
            const v4u* p = (const v4u*)(VB + (size_t)(g >> 1) * TILE_ELEMS + (size_t)(r0 + sp) * 256 + (g & 1) * 128 + cs);
#pragma unroll
            for (int i = 0; i < 4; ++i) { const v4u w = p[i]; const unsigned ww[4] = {w.x, w.y, w.z, w.w};
#pragma unroll
                for (int e = 0; e < 8; ++e) { const float xv = (e & 1) ? pg8::bf_hi(ww[e >> 1]) : pg8::bf_lo(ww[e >> 1]); const int c = cs + 8 * i + e;
                    const float y = (xv - st.x) * st.y * lng[128 * g + c] + lnb[128 * g + c];
                    vnT[c * VNT_LD + sp] = (bf16)f2bf(y); } }
        }
        __syncthreads();
        f32x16 acc[2];
#pragma unroll
        for (int nt = 0; nt < 2; ++nt)
#pragma unroll
            for (int r = 0; r < 16; ++r) acc[nt][r] = 0.f;
        const bf16* wrow = WsB + (size_t)(g * 128 + 32 * tt + cl) * 128 + 8 * hh;
        for (int ks = 0; ks < 2 * tt + 2; ++ks) {
            const bf16x8 a = *(const bf16x8*)(wrow + 16 * ks);
#pragma unroll
            for (int nt = 0; nt < 2; ++nt) { const bf16x8 b = *(const LAS bf16x8*)(vnT + (64 * ch + 32 * nt + cl) * VNT_LD + 16 * ks + 8 * hh);
                acc[nt] = __builtin_amdgcn_mfma_f32_32x32x16_bf16(a, b, acc[nt], 0, 0, 0); }
        }
#pragma unroll
        for (int nt = 0; nt < 2; ++nt)
#pragma unroll
            for (int r = 0; r < 16; ++r) { const int t = 32 * tt + (r & 3) + 8 * (r >> 2) + 4 * hh; const int c = 128 * g + 64 * ch + 32 * nt + cl;
                const size_t idx = (size_t)(r0 + t) * 512 + c; const float sv = acc[nt][r] + bsp[g * 128 + t];
                const size_t tix = (size_t)(g >> 1) * TILE_ELEMS + (size_t)(r0 + t) * 256 + (c & 255);
                YB[idx] = (bf16)f2bf(bf2f(U[tix]) * sv * bf2f(GB[tix])); }
        __syncthreads();
    }
}

constexpr unsigned KEY_NINF = 0x007FFFFFu;
__device__ __forceinline__ unsigned f2key(float s) { const unsigned u = __float_as_uint(s); return u ^ ((unsigned)((int)u >> 31) | 0x80000000u); }
typedef short v4i16_t __attribute__((ext_vector_type(4)));
__device__ __forceinline__ s16x4 vtr(const LAS bf16* p) { return __builtin_bit_cast(s16x4, __builtin_amdgcn_ds_read_tr16_b64_v4i16((LAS v4i16_t*)p)); }

struct AttnT { const bf16 *Q, *Kn, *Vv, *KI, *QI, *GA; const float* WI; bf16* YA; };

template <int P>
__device__ __forceinline__ unsigned idx_pass(const AttnT& A, const size_t rb, const int t0, const int lane_in, LAS unsigned short* list) {
    int lane = lane_in; asm volatile("" : "+v"(lane));
    const int H = lane >> 5, c = lane & 31;
    int tmax = t0 >> 5; asm volatile("" : "+s"(tmax));
    const int tq = t0 + 2 * H + P;
    unsigned key[64];
    {
        float w[8];
        { const GAS f32x4* wp = (const GAS f32x4*)(A.WI + (rb + tq) * 8); const f32x4 x0 = wp[0], x1 = wp[1];
#pragma unroll
          for (int i = 0; i < 4; ++i) { w[i] = x0[i]; w[4 + i] = x1[i]; } }
        const int ql = (c >> 4) + 2 * ((c >> 2) & 1), hd = (c & 3) + 4 * ((c >> 3) & 1);
        const GAS bf16* qp = (const GAS bf16*)(A.QI + (size_t)(hd >> 2) * TILE_ELEMS + (rb + t0 + ql) * 256 + (hd & 3) * 64 + 8 * H);
        bf16x8 aq[4];
#pragma unroll
        for (int ks = 0; ks < 4; ++ks) aq[ks] = *(const GAS bf16x8*)(qp + 16 * ks);
        const GAS char* kp = (const GAS char*)(A.KI + (rb + c) * 64 + 8 * H);
#pragma unroll
        for (int tg = 0; tg < 8; ++tg) {
            if (8 * tg <= tmax) {
                bf16x8 bn[4];
                { const int tl = 8 * tg < tmax ? 8 * tg : tmax;
#pragma unroll
                  for (int ks = 0; ks < 4; ++ks) bn[ks] = *(const GAS bf16x8*)(kp + (size_t)tl * 4096 + 32 * ks); }
#pragma unroll
                for (int ti = 0; ti < 8; ++ti) {
                    const int tile = 8 * tg + ti;
                    bf16x8 bk[4];
#pragma unroll
                    for (int ks = 0; ks < 4; ++ks) bk[ks] = bn[ks];
                    if (ti < 7) { const int tl = tile + 1 < tmax ? tile + 1 : tmax;
#pragma unroll
                        for (int ks = 0; ks < 4; ++ks) bn[ks] = *(const GAS bf16x8*)(kp + (size_t)tl * 4096 + 32 * ks); }
                    f32x16 D;
#pragma unroll
                    for (int r = 0; r < 16; ++r) D[r] = 0.f;
#pragma unroll
                    for (int ks = 0; ks < 4; ++ks) D = __builtin_amdgcn_mfma_f32_32x32x16_bf16(aq[ks], bk[ks], D, 0, 0, 0);
                    float s = 0.f;
#pragma unroll
                    for (int h = 0; h < 8; ++h) { const int di = __float_as_int(D[8 * P + h]); s = fmaf(w[h], __int_as_float(di > 0 ? di : 0), s); }
                    if (32 * tile + c > tq) s = -INFINITY;
                    key[tile] = f2key(s);
                    __builtin_amdgcn_sched_barrier(0);
                }
            } else {
#pragma unroll
                for (int ti = 0; ti < 8; ++ti) key[8 * tg + ti] = KEY_NINF;
            }
        }
    }
    unsigned Tk, need = 4096u;
    if (t0 >= 256) {
        Tk = 0u; bool done = false;
        for (int bit = 31; bit >= 0; --bit) {
            const unsigned cand = Tk | (1u << bit);
            unsigned cnt = 0u;
#pragma unroll
            for (int i = 0; i < 64; ++i) cnt += (key[i] >= cand) ? 1u : 0u;
            cnt += __shfl_xor(cnt, 1); cnt += __shfl_xor(cnt, 2); cnt += __shfl_xor(cnt, 4); cnt += __shfl_xor(cnt, 8); cnt += __shfl_xor(cnt, 16);
            if (!done) { if (cnt >= 256u) Tk = cand; if (cnt == 256u) done = true; }
            if (__all(done)) break;
        }
        if (!__all(done)) {
            unsigned cnt = 0u;
#pragma unroll
            for (int i = 0; i < 64; ++i) cnt += (key[i] > Tk) ? 1u : 0u;
            cnt += __shfl_xor(cnt, 1); cnt += __shfl_xor(cnt, 2); cnt += __shfl_xor(cnt, 4); cnt += __shfl_xor(cnt, 8); cnt += __shfl_xor(cnt, 16);
            if (!done) need = 256u - cnt;
        }
    } else { Tk = KEY_NINF + 1u; }
    unsigned nq = 0u;
    {
        unsigned tb = 0u; const unsigned ltm = (1u << c) - 1u;
        LAS unsigned short* lst = list + (2 * H + P) * 256;
#pragma unroll
        for (int tile = 0; tile < 64; ++tile) {
            if (tile <= tmax) {
                const unsigned kk = 32u * tile + c;
                const bool eq = key[tile] == Tk, gt = key[tile] > Tk;
                const unsigned long long me = __ballot(eq); const unsigned em = H ? (unsigned)(me >> 32) : (unsigned)me;
                const unsigned tr = tb + __popc(em & ltm); tb += __popc(em);
                const bool sel = gt || (eq && tr < need);
                const unsigned long long ms = __ballot(sel); const unsigned sm = H ? (unsigned)(ms >> 32) : (unsigned)ms;
                const unsigned pos = nq + __popc(sm & ltm); nq += __popc(sm);
                if (sel && pos < 256u) lst[pos] = (unsigned short)kk;
            }
        }
        nq = nq > 256u ? 256u : nq;
        if (nq + c < 256u) lst[nq + c] = 0;
    }
    return nq;
}

__device__ __forceinline__ void attn_wave_item(const AttnT& A, const int b, const int t0, LAS unsigned char* wl, const LAS unsigned char* bkt, const LAS float* biasb, const int lane_in) {
    int lane = lane_in; asm volatile("" : "+v"(lane));
    const size_t rb = (size_t)b * SEQ;
    LAS unsigned short* list = (LAS unsigned short*)wl;
    const unsigned nA = idx_pass<0>(A, rb, t0, lane, list);
    const unsigned nB = idx_pass<1>(A, rb, t0, lane, list);
    const int n0 = __shfl((int)nA, 0), n1 = __shfl((int)nB, 0), n2 = __shfl((int)nA, 32), n3 = __shfl((int)nB, 32);
    int lane3 = lane; asm volatile("" : "+v"(lane3));
    const int g = lane3 >> 4, hc = lane3 & 15;
    LAS bf16* Vs = (LAS bf16*)(wl + 2048);
    const float SC = 0.125f * LOG2E;
    for (int qi = 0; qi < 4; ++qi) {
        const int n = (qi == 0) ? n0 : ((qi == 1) ? n1 : ((qi == 2) ? n2 : n3));
        const int t = t0 + qi; const size_t qrow = rb + t;
        bf16x8 qB[2];
#pragma unroll
        for (int ks = 0; ks < 2; ++ks) {
            if (hc < 8) qB[ks] = *(const bf16x8*)(A.Q + qrow * 512 + hc * 64 + 32 * ks + 8 * g);
            else qB[ks] = (bf16x8){0, 0, 0, 0, 0, 0, 0, 0};
        }
        f32x4 O[4];
#pragma unroll
        for (int nt = 0; nt < 4; ++nt) O[nt] = (f32x4){0.f, 0.f, 0.f, 0.f};
        float lsum = 0.f;
        const LAS unsigned short* lq = list + qi * 256;
        const int ng = (n + 31) >> 5;
        for (int grp = 0; grp < ng; ++grp) {
            const int base = grp * 32;
            const unsigned kA0 = lq[base + hc], kA1 = lq[base + 16 + hc];
            bf16x8 a0[2], a1[2];
#pragma unroll
            for (int ks = 0; ks < 2; ++ks) { a0[ks] = *(const bf16x8*)(A.Kn + (rb + kA0) * 64 + 32 * ks + 8 * g); a1[ks] = *(const bf16x8*)(A.Kn + (rb + kA1) * 64 + 32 * ks + 8 * g); }
#pragma unroll
            for (int i = 0; i < 4; ++i) { const int row = i * 8 + (lane3 >> 3), chk = lane3 & 7; const unsigned kv = lq[base + row];
                const v4u val = *(const v4u*)(A.Vv + (rb + kv) * 64 + chk * 8); *(LAS v4u*)(Vs + row * VS_LD + chk * 8) = val; }
            f32x4 C0 = (f32x4){0.f, 0.f, 0.f, 0.f}, C1 = (f32x4){0.f, 0.f, 0.f, 0.f};
            C0 = __builtin_amdgcn_mfma_f32_16x16x32_bf16(a0[0], qB[0], C0, 0, 0, 0); C0 = __builtin_amdgcn_mfma_f32_16x16x32_bf16(a0[1], qB[1], C0, 0, 0, 0);
            C1 = __builtin_amdgcn_mfma_f32_16x16x32_bf16(a1[0], qB[0], C1, 0, 0, 0); C1 = __builtin_amdgcn_mfma_f32_16x16x32_bf16(a1[1], qB[1], C1, 0, 0, 0);
            const u32x2 ki0 = *(const LAS u32x2*)(lq + base + 4 * g), ki1 = *(const LAS u32x2*)(lq + base + 16 + 4 * g);
            float P0[4], P1[4];
#pragma unroll
            for (int r = 0; r < 4; ++r) {
                const unsigned w0 = (r < 2) ? ki0.x : ki0.y, w1 = (r < 2) ? ki1.x : ki1.y;
                const int k0i = (int)((w0 >> (16 * (r & 1))) & 0xffffu), k1i = (int)((w1 >> (16 * (r & 1))) & 0xffffu);
                int d0 = t - k0i, d1 = t - k1i; d0 = d0 < 0 ? 0 : d0; d1 = d1 < 0 ? 0 : d1;
                const float b0 = biasb[(int)bkt[d0] * 8 + (hc & 7)], b1 = biasb[(int)bkt[d1] * 8 + (hc & 7)];
                const float x0 = fmaf(C0[r], SC, b0), x1 = fmaf(C1[r], SC, b1);
                const float p0 = (base + 4 * g + r < n) ? __builtin_amdgcn_exp2f(x0) : 0.f, p1 = (base + 16 + 4 * g + r < n) ? __builtin_amdgcn_exp2f(x1) : 0.f;
                lsum += p0 + p1; P0[r] = p0; P1[r] = p1;
            }
            u32x4 pw; pw.x = pg8::cvt_pk_bf16(P0[0], P0[1]); pw.y = pg8::cvt_pk_bf16(P0[2], P0[3]); pw.z = pg8::cvt_pk_bf16(P1[0], P1[1]); pw.w = pg8::cvt_pk_bf16(P1[2], P1[3]);
            const bf16x8 pf = __builtin_bit_cast(bf16x8, pw);
            asm volatile("s_waitcnt lgkmcnt(0)" ::: "memory");
            const int tq = hc >> 2, tp = hc & 3;
#pragma unroll
            for (int nt = 0; nt < 4; ++nt) {
                const s16x4 r1 = vtr(Vs + (4 * g + tq) * VS_LD + 16 * nt + 4 * tp), r2 = vtr(Vs + (16 + 4 * g + tq) * VS_LD + 16 * nt + 4 * tp);
                const bf16x8 vb = (bf16x8){r1[0], r1[1], r1[2], r1[3], r2[0], r2[1], r2[2], r2[3]};
                O[nt] = __builtin_amdgcn_mfma_f32_16x16x32_bf16(pf, vb, O[nt], 0, 0, 0);
            }
            asm volatile("s_waitcnt lgkmcnt(0)" ::: "memory");
        }
        lsum += __shfl_xor(lsum, 16); lsum += __shfl_xor(lsum, 32);
        float linv[4];
#pragma unroll
        for (int r = 0; r < 4; ++r) linv[r] = 1.0f / __shfl(lsum, 4 * g + r);
        if (g < 2) {
#pragma unroll
            for (int r = 0; r < 4; ++r)
#pragma unroll
                for (int nt = 0; nt < 4; ++nt) { const size_t idx = qrow * 512 + (4 * g + r) * 64 + 16 * nt + hc;
                    const size_t gix = (size_t)g * TILE_ELEMS + qrow * 256 + r * 64 + 16 * nt + hc;
                    A.YA[idx] = (bf16)f2bf(O[nt][r] * linv[r] * bf2f(A.GA[gix])); }
        }
    }
}

__device__ __forceinline__ void p2_mixers(Frame& F0, int l) {
    Frame F = F0; { int t = F.tid; asm volatile("" : "+v"(t)); F.tid = t; F.lane = t & 63; }
    unsigned char* ws = F.ws;
    LAS unsigned char* bkt = F.lds + L_BKT; LAS float* biasb = (LAS float*)(F.lds + L_BIASB); LAS float* mfx = (LAS float*)(F.lds + L_MFIX);
    if (F.wave == 0) {
        const float gq = fabsf(F.q_norm_g[l * 64 + F.lane]), gk = fabsf(F.k_norm_g[l * 64 + F.lane]);
        float bm = 0.f;
#pragma unroll
        for (int i = 0; i < 4; ++i) bm = fmaxf(bm, fabsf(F.rel_bias[F.lane * 4 + i]));
        const float gqm = wave_max(gq), gkm = wave_max(gk), bmm = wave_max(bm);
        if (F.lane == 0) mfx[0] = 8.0f * gqm * gkm + bmm;
    }
    for (int d = F.tid; d < 2048; d += NWAVES * 64) {
        int bk;
        if (d < 16) bk = d; else { const float v = logf((float)d / 16.0f) / logf(8.0f) * 16.0f; bk = 16 + (int)v; bk = bk > 31 ? 31 : bk; }
        bkt[d] = (unsigned char)bk;
    }
    __syncthreads();
    if (F.tid < 256) biasb[F.tid] = (F.rel_bias[F.tid] - mfx[0]) * LOG2E;
    __syncthreads();
    for (int chn = F.vcu; chn < 256; chn += F.G) {
#ifndef NO_SGU
        sgu_chunk(F, chn * 128, (const bf16*)(ws + WS_VB), (const bf16*)(ws + WS_U), (const bf16*)(ws + WS_GB), (const bf16*)(ws + WS_WSP) + (size_t)l * 4 * 128 * 128,
                  F.b_spatial + l * 512, F.sgu_ln_g + l * 512, F.sgu_ln_b + l * 512, (bf16*)(ws + WS_YB));
#endif
    }
    const AttnT A{(const bf16*)(ws + WS_Q), (const bf16*)(ws + WS_K), (const bf16*)(ws + WS_V), (const bf16*)(ws + WS_KI), (const bf16*)(ws + WS_QI), (const bf16*)(ws + WS_GA), (const float*)(ws + WS_WI), (bf16*)(ws + WS_YA)};
    for (int gw = F.vcu * NWAVES + F.wave; gw < 2048; gw += F.G * NWAVES) {
        const int b = gw >> 7, j = gw & 127;
        LAS unsigned char* wl = F.lds + L_ATT + F.wave * ATT_WAVE_BYTES;
        for (int i = 0; i < 4; ++i) {
            const int qg = (i == 0) ? (511 - j) : ((i == 1) ? (256 + j) : ((i == 2) ? (255 - j) : j));
#ifndef NO_ATT
            attn_wave_item(A, b, 4 * qg, wl, bkt, biasb, F.lane);
#endif
        }
    }
}

struct Args { const float* in[12]; float* out; unsigned char* ws; };
__global__ void __launch_bounds__(NWAVES * 64, 2) fwd_mega(Args args) {
    extern __shared__ __attribute__((aligned(16))) unsigned char lds[];
    Frame F;
    F.lds = (LAS unsigned char*)lds;
    F.tid = threadIdx.x; F.lane = F.tid & 63; F.wave = __builtin_amdgcn_readfirstlane(F.tid >> 6);
    F.G = gridDim.x; { const int bx = blockIdx.x; F.vcu = (F.G % 8 == 0) ? (bx % 8) * (F.G / 8) + bx / 8 : bx; }
    F.x = args.in[0]; F.norm_g = args.in[1]; F.w_in = args.in[2]; F.q_norm_g = args.in[3]; F.k_norm_g = args.in[4]; F.rel_bias = args.in[5];
    F.sgu_ln_g = args.in[6]; F.sgu_ln_b = args.in[7]; F.w_spatial = args.in[8]; F.b_spatial = args.in[9]; F.w_branch = args.in[10]; F.w_out = args.in[11];
    F.out = args.out; F.ws = args.ws;
    unsigned char* ws = args.ws;
    for (int u = F.tid; u < (LDS_BYTES - LDSCTL_OFF) / 4; u += NWAVES * 64) ((LAS unsigned*)(F.lds + LDSCTL_OFF))[u] = 0u;
    __syncthreads();
    volatile LAS unsigned* MISC = (volatile LAS unsigned*)(F.lds + MISC_OFF);
    XcdBarrier bar = xcd_barrier_post((unsigned*)(ws + WS_CTL) + CW_BAR, MISC + 8);
#define GRID_BAR() xcd_barrier(bar)

#if !defined(PHM) || (PHM & 1)
    p0_prologue(F);
#endif
    GRID_BAR();
    for (int l = 0; l < 2; ++l) {
#if !defined(PHM) || (PHM & 2)
        {
            pg8::Gemm g{(const pg8::bf16_t*)(ws + WS_XN), (const pg8::bf16_t*)(ws + WS_WIN + l * WIN_LAYER), M, NIN, DM};
            pg8::StaticOrder S; S.init(M, NIN, F.G, (int)blockIdx.x);
            pg8::EpiIn E{ws, F.q_norm_g + l * 64, F.k_norm_g + l * 64, WS_Q, WS_K, WS_QI, WS_WI};
            pg8::gemm_phase<pg8::EpiIn, pg8::StaticOrder, true, true>(F.lds + RING_OFF, g, S, E);
        }
#endif
        GRID_BAR();
#if !defined(PHM) || (PHM & 4)
        p2_mixers(F, l);
#endif
        GRID_BAR();
#if !defined(PHM) || (PHM & 8)
        {
            pg8::StaticOrder S; S.init(M, DM, F.G, (int)blockIdx.x);
            { pg8::Gemm g{(const pg8::bf16_t*)(ws + WS_YA), (const pg8::bf16_t*)(ws + WS_WBR + (size_t)(l * 2 + 0) * MiB), M, DM, 512};
              pg8::EpiBrA E{(const pg8::bf16_t*)(ws + WS_MA), (pg8::bf16_t*)(ws + WS_T)};
              pg8::gemm_phase<pg8::EpiBrA, pg8::StaticOrder, true, true>(F.lds + RING_OFF, g, S, E); }
            { pg8::Gemm g{(const pg8::bf16_t*)(ws + WS_YB), (const pg8::bf16_t*)(ws + WS_WBR + (size_t)(l * 2 + 1) * MiB), M, DM, 512};
              pg8::EpiBrB E{(const pg8::bf16_t*)(ws + WS_MB), (pg8::bf16_t*)(ws + WS_T)};
              pg8::gemm_phase<pg8::EpiBrB, pg8::StaticOrder, true, true>(F.lds + RING_OFF, g, S, E); }
        }
#endif
        GRID_BAR();
#if !defined(PHM) || (PHM & 16)
        {
            pg8::Gemm g{(const pg8::bf16_t*)(ws + WS_T), (const pg8::bf16_t*)(ws + WS_WOUT + (size_t)l * 2 * MiB), M, DM, DM};
            pg8::StaticOrder S; S.init(M, DM, F.G, (int)blockIdx.x);
            pg8::EpiOut E{(l == 0) ? F.x : (const float*)F.out, F.out};
            pg8::gemm_phase<pg8::EpiOut, pg8::StaticOrder, true, true>(F.lds + RING_OFF, g, S, E);
        }
#endif
#if !defined(PHM) || (PHM & 32)
        if (l == 0) { GRID_BAR(); p5_renorm(F, F.out, F.norm_g + DM); GRID_BAR(); }
#endif
    }
#undef GRID_BAR
}

extern "C" void kernel_launch(void* const* d_in, const int* in_sizes, int n_in, void* d_out, int out_size, void* d_ws, size_t ws_size, hipStream_t stream) {
    static int grid = 0;
    if (grid == 0) {
        if (n_in != 12 || in_sizes[0] != M * DM || out_size != M * DM || ws_size < WS_END) { fprintf(stderr, "kernel_launch: unexpected shapes: n_in %d in0 %d out %d ws %zu (need %zu)\n", n_in, n_in > 0 ? in_sizes[0] : -1, out_size, ws_size, (size_t)WS_END); grid = -1; return; }
        int dev = 0, cus = 0, per_cu = 0;
        if (hipGetDevice(&dev) != hipSuccess || hipDeviceGetAttribute(&cus, hipDeviceAttributeMultiprocessorCount, dev) != hipSuccess) { fprintf(stderr, "kernel_launch: device query failed\n"); grid = -1; return; }
        if (hipFuncSetAttribute((const void*)fwd_mega, hipFuncAttributeMaxDynamicSharedMemorySize, LDS_BYTES) != hipSuccess) { fprintf(stderr, "kernel_launch: hipFuncSetAttribute failed\n"); grid = -1; return; }
        if (hipOccupancyMaxActiveBlocksPerMultiprocessor(&per_cu, (const void*)fwd_mega, NWAVES * 64, LDS_BYTES) != hipSuccess || per_cu < 1) { fprintf(stderr, "kernel_launch: occupancy query reports %d workgroups per CU\n", per_cu); }
        (void)hipGetLastError();
        grid = cus;
        if (grid != 256) fprintf(stderr, "kernel_launch: note: %d CUs\n", grid);
    }
    if (grid < 0) return;
    if (hipMemsetAsync((char*)d_ws + WS_CTL, 0, CTL_ZERO_BYTES, stream) != hipSuccess) { fprintf(stderr, "kernel_launch: memset failed\n"); return; }
    Args a{};
    for (int i = 0; i < 12; ++i) a.in[i] = (const float*)d_in[i];
    a.out = (float*)d_out; a.ws = (unsigned char*)d_ws;
    hipLaunchKernelGGL(fwd_mega, dim3(grid), dim3(NWAVES * 64), LDS_BYTES, stream, a);
    const hipError_t le = hipPeekAtLastError();
    if (le != hipSuccess) fprintf(stderr, "kernel_launch: launch failed: %s\n", hipGetErrorName(le));
}
```

```cpp
#include <hip/hip_runtime.h>
#include <cstdio>
#include <cstdint>
#include <cmath>
namespace pg8 {
#define PG8_LAS __attribute__((address_space(3)))
typedef unsigned short bf16_t;
typedef short bf16x8 __attribute__((ext_vector_type(8)));
typedef float f32x4 __attribute__((ext_vector_type(4)));
typedef unsigned u32x4 __attribute__((ext_vector_type(4)));
constexpr int BM = 256, BK = 64, HALF = 128, HTB = HALF * BK * 2  , STAGE_BYTES = 8 * HTB, NXCD = 8, WGM = 8;

__host__ __device__ __forceinline__ int lds_byte(int r, int c) { const int st = (r >> 4) * 2 + (c >> 5), rr = r & 15, cc = c & 31, ob = rr * 64 + cc * 2; return st * 1024 + (ob ^ (((ob >> 9) & 1) << 5)); }
__host__ __device__ __forceinline__ void stage_rc(int b, int& R, int& C) { const int st = b / 1024, sb = b % 1024, swz = sb ^ (((sb >> 9) & 1) << 5); R = (st >> 1) * 16 + swz / 64; C = (st & 1) * 32 + (swz % 64) / 2; }
__host__ __device__ __forceinline__ int perm32(int rho) { const int n = rho >> 4, i = rho & 15; return 8 * (i >> 2) + 4 * n + (i & 3); }

struct Unit { int pm, pn, seg; };
struct Gemm { const bf16_t* A; const bf16_t* Bt; int M, N, K; const bf16_t* A2; const bf16_t* Bt2; };

struct StaticOrder {
    int nM, nN, nwg, G, c;
    __host__ __device__ void init(int M, int N, int G_, int c_) { nM = M / BM; nN = N / BM; nwg = nM * nN; G = G_; c = c_; }
    __host__ __device__ bool next(int i, Unit& u) const {
        const long L = (long)i * G + c; if (L >= nwg) return false;
        int wgid = (int)L; { const int q = nwg / NXCD, r = nwg % NXCD, xcd = wgid % NXCD, off = wgid / NXCD; wgid = (xcd < r ? xcd * (q + 1) : r * (q + 1) + (xcd - r) * q) + off; }
        const int nig = WGM * nN, gid = wgid / nig, fm = gid * WGM, gsz = (nM - fm) < WGM ? (nM - fm) : WGM;
        u.pm = fm + ((wgid % nig) % gsz); u.pn = (wgid % nig) / gsz; u.seg = 0; return true;
    }
    __device__ __forceinline__ void a_ready(const Unit&) const {}
    __device__ __forceinline__ void done(const Unit&) const {}
};
struct TwoSegOrder {
    StaticOrder base;
    __host__ __device__ void init(int M, int N, int G_, int c_) { base.init(M, N, G_, c_); }
    __host__ __device__ bool next(int i, Unit& u) const { if (!base.next(i >> 1, u)) return false; u.seg = i & 1; return true; }
    __device__ __forceinline__ void a_ready(const Unit&) const {}
    __device__ __forceinline__ void done(const Unit&) const {}
};

typedef float f32x2_cv __attribute__((ext_vector_type(2))); typedef __bf16 bf16x2_cv __attribute__((ext_vector_type(2)));
__device__ __forceinline__ unsigned cvt_pk_bf16(float lo, float hi) { f32x2_cv v = {lo, hi}; bf16x2_cv b = __builtin_convertvector(v, bf16x2_cv); return __builtin_bit_cast(unsigned, b); }

typedef unsigned u32x2_e __attribute__((ext_vector_type(2)));
__device__ __forceinline__ float bf_lo(unsigned w) { return __uint_as_float(w << 16); }
__device__ __forceinline__ float bf_hi(unsigned w) { return __uint_as_float(w & 0xffff0000u); }
__device__ __forceinline__ float fast_sigmoid(float x) { return __builtin_amdgcn_rcpf(1.0f + __builtin_amdgcn_exp2f(-1.4426950408889634f * x)); }
typedef float f32x2_a __attribute__((ext_vector_type(2)));
__device__ __forceinline__ f32x2_a sig2_from_arg(f32x2_a a) {
    f32x2_a e2; e2.x = __builtin_amdgcn_exp2f(a.x); e2.y = __builtin_amdgcn_exp2f(a.y);
    const f32x2_a d = e2 + (f32x2_a){1.0f, 1.0f};
    f32x2_a r; r.x = __builtin_amdgcn_rcpf(d.x); r.y = __builtin_amdgcn_rcpf(d.y); return r;
}
__device__ __forceinline__ f32x2_a sigden2(f32x2_a x) {
    f32x2_a a = x * (f32x2_a){-1.4426950408889634f, -1.4426950408889634f}; a.x = fminf(a.x, 100.0f); a.y = fminf(a.y, 100.0f);
    f32x2_a e2; e2.x = __builtin_amdgcn_exp2f(a.x); e2.y = __builtin_amdgcn_exp2f(a.y); return e2 + (f32x2_a){1.0f, 1.0f};
}
__device__ __forceinline__ f32x2_a sigmoid2(f32x2_a x) { return sig2_from_arg(x * (f32x2_a){-1.4426950408889634f, -1.4426950408889634f}); }
__device__ __forceinline__ f32x2_a silu2(f32x2_a x) { return x * sigmoid2(x); }
__device__ __forceinline__ f32x2_a gelu2(f32x2_a x) {
    const f32x2_a t = (x * x) * (f32x2_a){-0.07135481627f * 1.4426950408889634f, -0.07135481627f * 1.4426950408889634f} + (f32x2_a){-1.5957691216f * 1.4426950408889634f, -1.5957691216f * 1.4426950408889634f};
    return x * sig2_from_arg(x * t);
}
__device__ __forceinline__ u32x4 pack8(const f32x4& a, const f32x4& b) { u32x4 w; w.x = cvt_pk_bf16(a[0], a[1]); w.y = cvt_pk_bf16(a[2], a[3]); w.z = cvt_pk_bf16(b[0], b[1]); w.w = cvt_pk_bf16(b[2], b[3]); return w; }

struct EpiIn {
    static constexpr bool PERM = true, AFTER_DRAIN = false, TWOSEG = false;
    unsigned char* ws; const float *qg, *kg;
    size_t oQ, oKVI, oTB, oWI;
    const float* rowss;
    mutable float rsc[8], rsn[8];
    __device__ __forceinline__ void pre(const Unit& u, int wr, int fr) const {
        if (rowss) { int fr_ = fr; asm volatile("" : "+v"(fr_)); const float* p = rowss + u.pm * BM + wr * 64 + fr_;
#pragma unroll
            for (int k = 0; k < 8; ++k) rsn[k] = p[(k >> 2) * HALF + (k & 3) * 16]; }
    }
    __device__ __forceinline__ void rot() const {
#pragma unroll
        for (int k = 0; k < 8; ++k) rsc[k] = rsn[k];
    }
    __device__ __forceinline__ void operator()(const f32x4 (&acc)[2][2][4][2], const Unit& u, int wr, int wc, int fr, int fq) const {
        if (rowss) {
            f32x4 (&ac)[2][2][4][2] = const_cast<f32x4 (&)[2][2][4][2]>(acc);
#pragma unroll
            for (int ai = 0; ai < 2; ++ai)
#pragma unroll
                for (int m = 0; m < 4; ++m) { const float sc = __builtin_amdgcn_rsqf(rsc[ai * 4 + m] * (1.0f / 1024.0f) + 1e-6f);
#pragma unroll
                    for (int bj = 0; bj < 2; ++bj)
#pragma unroll
                        for (int n = 0; n < 2; ++n) ac[ai][bj][m][n] *= sc; }
        }
        asm volatile("" : "+v"(fr), "+v"(fq));
        int pn = u.pn; asm volatile("" : "+s"(pn));
        const int row0 = u.pm * BM + wr * 64 + fr;
        if (pn < 2) {
            bf16_t* dst = (bf16_t*)(ws + oQ) + (4 * pn + wc) * 64 + 8 * fq;
#pragma unroll
            for (int ai = 0; ai < 2; ++ai)
#pragma unroll
                for (int m = 0; m < 4; ++m) {
                    const int row = row0 + ai * HALF + m * 16;
                    float ss = 0.f;
#pragma unroll
                    for (int bj = 0; bj < 2; ++bj)
#pragma unroll
                        for (int n = 0; n < 2; ++n) { const f32x4 x = acc[ai][bj][m][n]; ss += (x[0] * x[0] + x[1] * x[1]) + (x[2] * x[2] + x[3] * x[3]); }
                    ss += __shfl_xor(ss, 16); ss += __shfl_xor(ss, 32);
                    const float rs = 1.0f / sqrtf(ss * (1.0f / 64.0f) + 1e-6f);
#pragma unroll
                    for (int bj = 0; bj < 2; ++bj) {
                        const f32x4 v0 = acc[ai][bj][m][0] * rs * *(const f32x4*)(qg + 32 * bj + 8 * fq), v1 = acc[ai][bj][m][1] * rs * *(const f32x4*)(qg + 32 * bj + 8 * fq + 4);
                        *(u32x4*)(dst + (size_t)row * 512 + 32 * bj) = pack8(v0, v1);
                    }
                    asm volatile("" ::: "memory");
                }
        } else if (pn == 2) {
            bf16_t* dst = (bf16_t*)(ws + oKVI + (size_t)wc * (4u << 20)) + 8 * fq;
            float* WI = (float*)(ws + oWI);
#pragma unroll
            for (int ai = 0; ai < 2; ++ai)
#pragma unroll
                for (int m = 0; m < 4; ++m) {
                    const int row = row0 + ai * HALF + m * 16;
                    float ss = 0.f;
#pragma unroll
                    for (int bj = 0; bj < 2; ++bj)
#pragma unroll
                        for (int n = 0; n < 2; ++n) { const f32x4 x = acc[ai][bj][m][n]; ss += (x[0] * x[0] + x[1] * x[1]) + (x[2] * x[2] + x[3] * x[3]); }
                    ss += __shfl_xor(ss, 16); ss += __shfl_xor(ss, 32);
                    const float rs = (wc == 0) ? 1.0f / sqrtf(ss * (1.0f / 64.0f) + 1e-6f) : 1.0f;
                    if (wc == 3) { if (fq == 0) { *(f32x4*)(WI + (size_t)row * 8) = acc[ai][0][m][0]; *(f32x4*)(WI + (size_t)row * 8 + 4) = acc[ai][0][m][1]; } }
                    else if (wc == 2) {
#pragma unroll
                        for (int bj = 0; bj < 2; ++bj) *(u32x4*)((bf16_t*)(ws + oKVI + (size_t)2 * (4u << 20)) + ((size_t)(4 * bj + fq) * 32768 + row) * 8) = pack8(acc[ai][bj][m][0], acc[ai][bj][m][1]);
                    } else {
#pragma unroll
                        for (int bj = 0; bj < 2; ++bj) {
                            f32x4 g0 = *(const f32x4*)(kg + 32 * bj + 8 * fq), g1 = *(const f32x4*)(kg + 32 * bj + 8 * fq + 4);
                            if (wc != 0) { g0 = (f32x4){1.f, 1.f, 1.f, 1.f}; g1 = g0; }
                            const f32x4 v0 = acc[ai][bj][m][0] * rs * g0, v1 = acc[ai][bj][m][1] * rs * g1;
                            *(u32x4*)(dst + (size_t)row * 64 + 32 * bj) = pack8(v0, v1);
                        }
                    }
                    asm volatile("" ::: "memory");
                }
        } else {
            bf16_t* dst = (bf16_t*)(ws + oTB + (size_t)(pn - 3) * (16u << 20)) + 32 * wc + 8 * fq;
            const int mode = (pn < 5) ? 0 : ((pn >= 13) ? 3 : ((pn >= 7 && pn < 11) ? 2 : 1));
#define EPI_N_LOOP(BODY) _Pragma("unroll") for (int ai = 0; ai < 2; ++ai) _Pragma("unroll") for (int m = 0; m < 4; ++m) { const int row = row0 + ai * HALF + m * 16; \
                _Pragma("unroll") for (int bj = 0; bj < 2; ++bj) { f32x4 v0 = acc[ai][bj][m][0], v1 = acc[ai][bj][m][1]; \
                    _Pragma("unroll") for (int i = 0; i < 2; ++i) { f32x2_a x = (f32x2_a){v0[2 * i], v0[2 * i + 1]}; BODY; v0[2 * i] = x.x; v0[2 * i + 1] = x.y; x = (f32x2_a){v1[2 * i], v1[2 * i + 1]}; BODY; v1[2 * i] = x.x; v1[2 * i + 1] = x.y; } \
                    *(u32x4*)(dst + (size_t)row * 256 + 128 * bj) = pack8(v0, v1); } \
                asm volatile("" ::: "memory"); }
            if (pn >= 13) {
                const int t = pn - 13;
                bf16_t* dR = (bf16_t*)(ws + oTB + (size_t)(10 + (t >> 1)) * (16u << 20)) + (t & 1) * 128 + 32 * wc + 8 * fq;
                bf16_t* dS = (bf16_t*)(ws + oTB + (size_t)(14 + (t >> 1)) * (16u << 20)) + (t & 1) * 128 + 32 * wc + 8 * fq;
#pragma unroll
                for (int ai = 0; ai < 2; ++ai)
#pragma unroll
                    for (int m = 0; m < 4; ++m) { const int row = row0 + ai * HALF + m * 16;
                        f32x4 rr[2], ss[2];
#pragma unroll
                        for (int n = 0; n < 2; ++n)
#pragma unroll
                            for (int i = 0; i < 2; ++i) {
                                const f32x2_a xa = (f32x2_a){acc[ai][0][m][n][2 * i], acc[ai][0][m][n][2 * i + 1]}, xb = (f32x2_a){acc[ai][1][m][n][2 * i], acc[ai][1][m][n][2 * i + 1]};
                                const f32x2_a ea = sigden2(xa), eb = sigden2(xb);
                                f32x2_a ia, ib; ia.x = __builtin_amdgcn_rcpf(ea.x); ia.y = __builtin_amdgcn_rcpf(ea.y); ib.x = __builtin_amdgcn_rcpf(eb.x); ib.y = __builtin_amdgcn_rcpf(eb.y);
                                const f32x2_a r = eb * ia;
                                rr[n][2 * i] = r.x; rr[n][2 * i + 1] = r.y; ss[n][2 * i] = ib.x; ss[n][2 * i + 1] = ib.y;
                            }
                        *(u32x4*)(dR + (size_t)row * 256) = pack8(rr[0], rr[1]); *(u32x4*)(dS + (size_t)row * 256) = pack8(ss[0], ss[1]);
                        asm volatile("" ::: "memory"); }
            }
            else if (pn == 7 || pn == 8 || pn == 11 || pn == 12) {
                const int t = (pn == 7) ? 0 : (pn == 8) ? 1 : (pn == 11) ? 2 : 3;
                bf16_t* dP = (bf16_t*)(ws + oTB + (size_t)(4 + (t >> 1)) * (16u << 20)) + (t & 1) * 128 + 32 * wc + 8 * fq;
#pragma unroll
                for (int ai = 0; ai < 2; ++ai)
#pragma unroll
                    for (int m = 0; m < 4; ++m) { const int row = row0 + ai * HALF + m * 16;
                        f32x4 pp[2];
#pragma unroll
                        for (int n = 0; n < 2; ++n)
#pragma unroll
                            for (int i = 0; i < 2; ++i) {
                                const f32x2_a xu = (f32x2_a){acc[ai][0][m][n][2 * i], acc[ai][0][m][n][2 * i + 1]}, xg = (f32x2_a){acc[ai][1][m][n][2 * i], acc[ai][1][m][n][2 * i + 1]};
                                const f32x2_a pr = gelu2(xu) * silu2(xg);
                                pp[n][2 * i] = pr.x; pp[n][2 * i + 1] = pr.y;
                            }
                        *(u32x4*)(dP + (size_t)row * 256) = pack8(pp[0], pp[1]);
                        asm volatile("" ::: "memory"); }
            }
            else if (mode == 0) { EPI_N_LOOP((void)0) }
            else if (mode == 1) { EPI_N_LOOP(x = silu2(x)) }
            else if (mode == 2) { EPI_N_LOOP(x = gelu2(x)) }
            else                { EPI_N_LOOP(x = sigmoid2(x)) }
#undef EPI_N_LOOP
        }
    }
};

struct EpiBrA {
    static constexpr bool PERM = true, AFTER_DRAIN = false, TWOSEG = false;
    const bf16_t* G; bf16_t* T;
    __device__ __forceinline__ void operator()(const f32x4 (&acc)[2][2][4][2], const Unit& u, int wr, int wc, int fr, int fq) const {
        asm volatile("" : "+v"(fr), "+v"(fq));
        const int row0 = u.pm * BM + wr * 64 + fr, colw = u.pn * BM + 32 * wc + 8 * fq;
#pragma unroll
        for (int ai = 0; ai < 2; ++ai)
#pragma unroll
            for (int m = 0; m < 4; ++m) {
                const size_t ro = (size_t)(row0 + ai * HALF + m * 16) * 1024 + colw;
#pragma unroll
                for (int bj = 0; bj < 2; ++bj) {
                    const u32x4 gw = *(const u32x4*)(G + (size_t)u.pn * ((size_t)8 << 20) + (size_t)(row0 + ai * HALF + m * 16) * 256 + (32 * wc + 8 * fq) + 128 * bj);
                    f32x4 v0 = acc[ai][bj][m][0], v1 = acc[ai][bj][m][1];
                    v0[0] *= bf_lo(gw.x); v0[1] *= bf_hi(gw.x); v0[2] *= bf_lo(gw.y); v0[3] *= bf_hi(gw.y);
                    v1[0] *= bf_lo(gw.z); v1[1] *= bf_hi(gw.z); v1[2] *= bf_lo(gw.w); v1[3] *= bf_hi(gw.w);
                    *(u32x4*)(T + ro + 128 * bj) = pack8(v0, v1);
                }
                asm volatile("" ::: "memory");
            }
    }
};
struct EpiBrB {
    static constexpr bool PERM = true, AFTER_DRAIN = false, TWOSEG = false;
    const bf16_t* G; bf16_t* T;
    __device__ __forceinline__ void operator()(const f32x4 (&acc)[2][2][4][2], const Unit& u, int wr, int wc, int fr, int fq) const {
        asm volatile("" : "+v"(fr), "+v"(fq));
        const int row0 = u.pm * BM + wr * 64 + fr, colw = u.pn * BM + 32 * wc + 8 * fq;
#pragma unroll
        for (int ai = 0; ai < 2; ++ai)
#pragma unroll
            for (int m = 0; m < 4; ++m) {
                const size_t ro = (size_t)(row0 + ai * HALF + m * 16) * 1024 + colw;
#pragma unroll
                for (int bj = 0; bj < 2; ++bj) {
                    const u32x4 gw = *(const u32x4*)(G + (size_t)u.pn * ((size_t)8 << 20) + (size_t)(row0 + ai * HALF + m * 16) * 256 + (32 * wc + 8 * fq) + 128 * bj);
                    const u32x4 tw = *(const u32x4*)(T + ro + 128 * bj);
                    f32x4 v0 = acc[ai][bj][m][0], v1 = acc[ai][bj][m][1];
                    v0[0] = v0[0] * bf_lo(gw.x) + bf_lo(tw.x); v0[1] = v0[1] * bf_hi(gw.x) + bf_hi(tw.x); v0[2] = v0[2] * bf_lo(gw.y) + bf_lo(tw.y); v0[3] = v0[3] * bf_hi(gw.y) + bf_hi(tw.y);
                    v1[0] = v1[0] * bf_lo(gw.z) + bf_lo(tw.z); v1[1] = v1[1] * bf_hi(gw.z) + bf_hi(tw.z); v1[2] = v1[2] * bf_lo(gw.w) + bf_lo(tw.w); v1[3] = v1[3] * bf_hi(gw.w) + bf_hi(tw.w);
                    *(u32x4*)(T + ro + 128 * bj) = pack8(v0, v1);
                }
                asm volatile("" ::: "memory");
            }
    }
};
struct EpiOut {
    __device__ __forceinline__ void pre(const Unit&, int, int) const {}
    __device__ __forceinline__ void rot() const {}
    static constexpr bool PERM = false, AFTER_DRAIN = false, TWOSEG = false;
    const float* base32; const bf16_t* base16; float* out32; bf16_t* out16; int last; float* rowss;
    __device__ __forceinline__ void operator()(const f32x4 (&acc)[2][2][4][2], const Unit& u, int wr, int wc, int fr, int fq) const {
        asm volatile("" : "+v"(fr), "+v"(fq));
        const int row0 = u.pm * BM + wr * 64 + fr, col0 = u.pn * BM + wc * 32 + 4 * fq;
        if (!last) {
#pragma unroll
            for (int ai = 0; ai < 2; ++ai)
#pragma unroll
                for (int m = 0; m < 4; ++m) {
                    const size_t ro = (size_t)(row0 + ai * HALF + m * 16) * 1024 + col0;
                    float ssq = 0.f;
#pragma unroll
                    for (int bj = 0; bj < 2; ++bj)
#pragma unroll
                        for (int n = 0; n < 2; ++n) { const f32x4 b = *(const f32x4*)(base32 + ro + bj * HALF + n * 16); const f32x4 v = b + acc[ai][bj][m][n];
                            ssq += (v[0] * v[0] + v[1] * v[1]) + (v[2] * v[2] + v[3] * v[3]);
                            u32x2_e o; o.x = cvt_pk_bf16(v[0], v[1]); o.y = cvt_pk_bf16(v[2], v[3]); *(u32x2_e*)(out16 + ro + bj * HALF + n * 16) = o; }
                    { const unsigned xi = __float_as_uint(ssq); const auto s16 = __builtin_amdgcn_permlane16_swap(xi, xi, false, false); ssq = __uint_as_float(s16[0]) + __uint_as_float(s16[1]); }
                    { const unsigned xi = __float_as_uint(ssq); const auto s32 = __builtin_amdgcn_permlane32_swap(xi, xi, false, false); ssq = __uint_as_float(s32[0]) + __uint_as_float(s32[1]); }
                    if (fq == 0) __hip_atomic_fetch_add(rowss + (row0 + ai * HALF + m * 16), ssq, __ATOMIC_RELAXED, __HIP_MEMORY_SCOPE_AGENT);
                }
        } else {
#pragma unroll
            for (int ai = 0; ai < 2; ++ai)
#pragma unroll
                for (int m = 0; m < 4; ++m) {
                    const size_t ro = (size_t)(row0 + ai * HALF + m * 16) * 1024 + col0;
#pragma unroll
                    for (int bj = 0; bj < 2; ++bj)
#pragma unroll
                        for (int n = 0; n < 2; ++n) { const u32x2_e w = *(const u32x2_e*)(base16 + ro + bj * HALF + n * 16);
                            const f32x4 b = (f32x4){bf_lo(w.x), bf_hi(w.x), bf_lo(w.y), bf_hi(w.y)}; *(f32x4*)(out32 + ro + bj * HALF + n * 16) = b + acc[ai][bj][m][n]; }
                }
        }
    }
};

struct EpiMerge {
    __device__ __forceinline__ void pre(const Unit&, int, int) const {}
    __device__ __forceinline__ void rot() const {}
    static constexpr bool PERM = true, AFTER_DRAIN = false, TWOSEG = true;
    const bf16_t* GA; const bf16_t* GB; bf16_t* T;
    __device__ __forceinline__ void mid(f32x4 (&acc)[2][2][4][2], const Unit& u, int wr, int wc, int fr, int fq) const {
        asm volatile("" : "+v"(fr), "+v"(fq));
        const int row0 = u.pm * BM + wr * 64 + fr;
        const size_t tb = (size_t)u.pn * ((size_t)8 << 20) + (32 * wc + 8 * fq);
        u32x4 aw[2][2];
#define MG_LOAD(slot, k) do { const size_t go_ = tb + (size_t)(row0 + ((k) >> 2) * HALF + ((k) & 3) * 16) * 256; \
            aw[slot][0] = *(const u32x4*)(GA + go_); aw[slot][1] = *(const u32x4*)(GA + go_ + 128); } while (0)
        MG_LOAD(0, 0);
#pragma unroll
        for (int k = 0; k < 8; ++k) {
            const int ai = k >> 2, m = k & 3, s = k & 1;
            if (k < 7) MG_LOAD(s ^ 1, k + 1);
#pragma unroll
            for (int bj = 0; bj < 2; ++bj) {
                const unsigned aws[4] = {aw[s][bj].x, aw[s][bj].y, aw[s][bj].z, aw[s][bj].w};
#pragma unroll
                for (int i = 0; i < 4; ++i) {
                    const float r0 = bf_lo(aws[i]), r1 = bf_hi(aws[i]);
                    if (i < 2) { acc[ai][bj][m][0][2 * i] *= r0; acc[ai][bj][m][0][2 * i + 1] *= r1; } else { acc[ai][bj][m][1][2 * i - 4] *= r0; acc[ai][bj][m][1][2 * i - 3] *= r1; }
                }
            }
        }
#undef MG_LOAD
    }
    __device__ __forceinline__ void operator()(const f32x4 (&acc)[2][2][4][2], const Unit& u, int wr, int wc, int fr, int fq) const {
        asm volatile("" : "+v"(fr), "+v"(fq));
        const int row0 = u.pm * BM + wr * 64 + fr, colw = u.pn * BM + 32 * wc + 8 * fq;
        const size_t tb = (size_t)u.pn * ((size_t)8 << 20) + (32 * wc + 8 * fq);
        u32x4 gw[2][2];
#define MG_LOAD(slot, k) do { const size_t go_ = tb + (size_t)(row0 + ((k) >> 2) * HALF + ((k) & 3) * 16) * 256; gw[slot][0] = *(const u32x4*)(GB + go_); gw[slot][1] = *(const u32x4*)(GB + go_ + 128); } while (0)
        MG_LOAD(0, 0);
#pragma unroll
        for (int k = 0; k < 8; ++k) {
            const int ai = k >> 2, m = k & 3, s = k & 1;
            if (k < 7) MG_LOAD(s ^ 1, k + 1);
            const size_t ro = (size_t)(row0 + ai * HALF + m * 16) * 1024 + colw;
#pragma unroll
            for (int bj = 0; bj < 2; ++bj) {
                const u32x4 g = gw[s][bj];
                f32x4 v0 = acc[ai][bj][m][0], v1 = acc[ai][bj][m][1];
                v0[0] *= bf_lo(g.x); v0[1] *= bf_hi(g.x); v0[2] *= bf_lo(g.y); v0[3] *= bf_hi(g.y);
                v1[0] *= bf_lo(g.z); v1[1] *= bf_hi(g.z); v1[2] *= bf_lo(g.w); v1[3] *= bf_hi(g.w);
                *(u32x4*)(T + ro + 128 * bj) = pack8(v0, v1);
            }
        }
#undef MG_LOAD
    }
};
template <class Epi, class Sched, bool ALIGN_EPI = false, bool SP2 = false>
__device__ __forceinline__ void gemm_phase(PG8_LAS unsigned char* lds, const Gemm g, const Sched& S, const Epi& E) {
    int tid = threadIdx.x; asm volatile("" : "+v"(tid));
    const int wid = __builtin_amdgcn_readfirstlane(tid >> 6), lane = tid & 63, wr = wid >> 2, wc = wid & 3, fr = lane & 15, fq = lane >> 4;
    const int K = g.K, nt = K / BK;
    unsigned voffA[2], voffB[2];
#pragma unroll
    for (int i = 0; i < 2; ++i) { int R, C; stage_rc(tid * 16 + i * 8192, R, C); const int Rb = Epi::PERM ? ((R & ~31) + perm32(R & 31)) : R;
        voffA[i] = (unsigned)(R * K + C) * 2u; voffB[i] = (unsigned)(Rb * K + C) * 2u; }
    const size_t kstep = (size_t)(BK * 2);
    const size_t hstep = (size_t)HALF * K * 2;
    const size_t tstep = 2 * hstep;
    const unsigned ldsw = (unsigned)wid * 1024u;
    const int aoff = lds_byte(wr * 64 + fr, fq * 8), boff = lds_byte(wc * 32 + fr, fq * 8);
#define PG8_SA(b, h) (((b) * 2 + (h)) * HTB)
#define PG8_SB(b, h) ((4 + (b) * 2 + (h)) * HTB)
#define PG8_STAGE(bufoff, gbase, voff) do { _Pragma("unroll") for (int _i = 0; _i < 2; ++_i) \
        __builtin_amdgcn_global_load_lds((const unsigned*)((const char*)(gbase) + (voff)[_i]), (PG8_LAS unsigned*)(lds + (bufoff) + ldsw + _i * 8192), 16, 0, 0); } while (0)
#define PG8_LDA(dst, b, h) do { _Pragma("unroll") for (int m = 0; m < 4; ++m) _Pragma("unroll") for (int k = 0; k < 2; ++k) dst[m][k] = *(const PG8_LAS bf16x8*)(lds + PG8_SA(b, h) + aoff + m * 2048 + k * 1024); } while (0)
#define PG8_LDB(dst, b, h) do { _Pragma("unroll") for (int n = 0; n < 2; ++n) _Pragma("unroll") for (int k = 0; k < 2; ++k) dst[n][k] = *(const PG8_LAS bf16x8*)(lds + PG8_SB(b, h) + boff + n * 2048 + k * 1024); } while (0)
#define PG8_MMA(ai, bj, At, Bt) do { __builtin_amdgcn_s_setprio(1); _Pragma("unroll") for (int m = 0; m < 4; ++m) _Pragma("unroll") for (int n = 0; n < 2; ++n) _Pragma("unroll") for (int k = 0; k < 2; ++k) \
        acc[ai][bj][m][n] = __builtin_amdgcn_mfma_f32_16x16x32_bf16(Bt[n][k], At[m][k], acc[ai][bj][m][n], 0, 0, 0); __builtin_amdgcn_s_setprio(0); } while (0)
#define PG8_WAIT_V(n) asm volatile("s_waitcnt vmcnt(" #n ")" ::: "memory")
#define PG8_WAIT_L(n) asm volatile("s_waitcnt lgkmcnt(" #n ")" ::: "memory")
#define PG8_BAR __builtin_amdgcn_s_barrier()
#define PG8_SCHED __builtin_amdgcn_sched_barrier(0)
    Unit cur, nxt; int ui = 0;
    if (!S.next(0, cur)) return;
    E.pre(cur, wr, fr); E.rot();
    f32x4 acc[2][2][4][2];
#pragma unroll
    for (int a = 0; a < 2; ++a)
#pragma unroll
        for (int b = 0; b < 2; ++b)
#pragma unroll
            for (int m = 0; m < 4; ++m)
#pragma unroll
                for (int n = 0; n < 2; ++n) acc[a][b][m][n] = (f32x4){0.f, 0.f, 0.f, 0.f};
    bf16x8 At[4][2], B0[2][2], B1[2][2];
    const char* cA = (const char*)((Epi::TWOSEG && cur.seg) ? g.A2 : g.A) + (size_t)cur.pm * tstep; const char* cB = (const char*)((Epi::TWOSEG && cur.seg) ? g.Bt2 : g.Bt) + (size_t)cur.pn * tstep;
    S.a_ready(cur);
    if constexpr (SP2) {
        PG8_STAGE(PG8_SB(0, 0), cB, voffB); PG8_STAGE(PG8_SB(0, 1), cB + hstep, voffB); PG8_STAGE(PG8_SA(0, 0), cA, voffA); PG8_STAGE(PG8_SA(0, 1), cA + hstep, voffA);
        if (wr == 1) PG8_BAR;
        PG8_WAIT_V(2); PG8_BAR;
        PG8_STAGE(PG8_SB(1, 0), cB + kstep, voffB); PG8_STAGE(PG8_SA(1, 0), cA + kstep, voffA); PG8_STAGE(PG8_SB(1, 1), cB + hstep + kstep, voffB);
        PG8_WAIT_V(6); PG8_BAR;
    } else {
        PG8_STAGE(PG8_SB(0, 0), cB, voffB); PG8_STAGE(PG8_SA(0, 0), cA, voffA); PG8_STAGE(PG8_SB(0, 1), cB + hstep, voffB); PG8_STAGE(PG8_SA(0, 1), cA + hstep, voffA);
        if (wr == 1) PG8_BAR;
        PG8_WAIT_V(4); PG8_BAR;
        PG8_STAGE(PG8_SB(1, 0), cB + kstep, voffB); PG8_STAGE(PG8_SA(1, 0), cA + kstep, voffA); PG8_STAGE(PG8_SB(1, 1), cB + hstep + kstep, voffB);
        PG8_WAIT_V(6); PG8_BAR;
    }
    for (;;) {
        const bool has_next = S.next(ui + 1, nxt);
        const char* nA = has_next ? (const char*)((Epi::TWOSEG && nxt.seg) ? g.A2 : g.A) + (size_t)nxt.pm * tstep : cA; const char* nB = has_next ? (const char*)((Epi::TWOSEG && nxt.seg) ? g.Bt2 : g.Bt) + (size_t)nxt.pn * tstep : cB;
        for (int t = 0; t < nt; t += 2) {
            const bool last = (t == nt - 2);
            const char* a1 = cA + (size_t)(t + 1) * kstep;
            const char* a2 = last ? nA : cA + (size_t)(t + 2) * kstep; const char* b2 = last ? nB : cB + (size_t)(t + 2) * kstep;
            const char* a3 = a2 + kstep; const char* b3 = b2 + kstep;
            if (last && has_next) S.a_ready(nxt);
            if constexpr (SP2) {
            PG8_LDB(B0, 0, 0); PG8_LDB(B1, 0, 1); PG8_SCHED; PG8_LDA(At, 0, 0); PG8_STAGE(PG8_SA(1, 1), a1 + hstep, voffA);
            PG8_WAIT_V(8); PG8_WAIT_L(0); PG8_BAR; PG8_MMA(0, 0, At, B0); PG8_MMA(0, 1, At, B1); PG8_BAR; PG8_SCHED;
            PG8_LDA(At, 0, 1); PG8_STAGE(PG8_SB(0, 0), b2, voffB); PG8_STAGE(PG8_SB(0, 1), b2 + hstep, voffB); PG8_STAGE(PG8_SA(0, 0), a2, voffA);
            PG8_WAIT_V(8); PG8_WAIT_L(0); PG8_BAR; PG8_MMA(1, 0, At, B0); PG8_MMA(1, 1, At, B1); PG8_BAR; PG8_SCHED;
            PG8_LDB(B0, 1, 0); PG8_LDB(B1, 1, 1); PG8_SCHED; PG8_LDA(At, 1, 0); PG8_STAGE(PG8_SA(0, 1), a2 + hstep, voffA);
            PG8_WAIT_V(8); PG8_WAIT_L(0); PG8_BAR; PG8_MMA(0, 0, At, B0); PG8_MMA(0, 1, At, B1); PG8_BAR; PG8_SCHED;
            PG8_LDA(At, 1, 1); PG8_STAGE(PG8_SB(1, 0), b3, voffB); PG8_STAGE(PG8_SB(1, 1), b3 + hstep, voffB); PG8_STAGE(PG8_SA(1, 0), a3, voffA);
            PG8_WAIT_V(8); PG8_WAIT_L(0); PG8_BAR; PG8_MMA(1, 0, At, B0); PG8_MMA(1, 1, At, B1); PG8_BAR; PG8_SCHED;
            } else {
            PG8_LDB(B0, 0, 0); PG8_SCHED; PG8_LDA(At, 0, 0); PG8_STAGE(PG8_SA(1, 1), a1 + hstep, voffA);
            PG8_WAIT_L(8); PG8_BAR; PG8_WAIT_L(0); PG8_MMA(0, 0, At, B0); PG8_BAR; PG8_SCHED;
            PG8_LDB(B1, 0, 1); PG8_STAGE(PG8_SB(0, 0), b2, voffB);
            PG8_BAR; PG8_WAIT_L(0); PG8_MMA(0, 1, At, B1); PG8_BAR;
            PG8_LDA(At, 0, 1); PG8_STAGE(PG8_SA(0, 0), a2, voffA);
            PG8_BAR; PG8_WAIT_L(0); PG8_MMA(1, 0, At, B0); PG8_BAR; PG8_SCHED;
            PG8_STAGE(PG8_SB(0, 1), b2 + hstep, voffB);
            PG8_WAIT_V(6); PG8_BAR; PG8_MMA(1, 1, At, B1); PG8_BAR;
            PG8_LDB(B0, 1, 0); PG8_SCHED; PG8_LDA(At, 1, 0); PG8_STAGE(PG8_SA(0, 1), a2 + hstep, voffA);
            PG8_WAIT_L(8); PG8_BAR; PG8_WAIT_L(0); PG8_MMA(0, 0, At, B0); PG8_BAR; PG8_SCHED;
            PG8_LDB(B1, 1, 1); PG8_STAGE(PG8_SB(1, 0), b3, voffB);
            PG8_BAR; PG8_WAIT_L(0); PG8_MMA(0, 1, At, B1); PG8_BAR;
            PG8_LDA(At, 1, 1); PG8_STAGE(PG8_SA(1, 0), a3, voffA);
            PG8_BAR; PG8_WAIT_L(0); PG8_MMA(1, 0, At, B0); PG8_BAR; PG8_SCHED;
            PG8_STAGE(PG8_SB(1, 1), b3 + hstep, voffB);
            PG8_WAIT_V(6); PG8_BAR; PG8_MMA(1, 1, At, B1); PG8_BAR;
            }
        }
        if constexpr (ALIGN_EPI) { if (wr == 0) PG8_BAR; }
        if (has_next) E.pre(nxt, wr, fr);
        if constexpr (!Epi::AFTER_DRAIN) { if constexpr (Epi::TWOSEG) { if (cur.seg == 0) E.mid(acc, cur, wr, wc, fr, fq); else E(acc, cur, wr, wc, fr, fq); } else { E(acc, cur, wr, wc, fr, fq); } S.done(cur); }   E.rot();
        if (!has_next) break;
        if (!(Epi::TWOSEG && cur.seg == 0)) {
#pragma unroll
        for (int a = 0; a < 2; ++a)
#pragma unroll
            for (int b = 0; b < 2; ++b)
#pragma unroll
                for (int m = 0; m < 4; ++m)
#pragma unroll
                    for (int n = 0; n < 2; ++n) acc[a][b][m][n] = (f32x4){0.f, 0.f, 0.f, 0.f};
        }
        cur = nxt; cA = nA; cB = nB; ++ui;
        if constexpr (ALIGN_EPI) { if (wr == 1) PG8_BAR; }
    }
    PG8_WAIT_V(0);
    if constexpr (!ALIGN_EPI) { if (wr == 0) PG8_BAR; }
    PG8_BAR;
    if constexpr (Epi::AFTER_DRAIN) { E.fused(acc, cur, wr, wc, fr, fq, lds, wid, lane); S.done(cur); }
#undef PG8_SA
#undef PG8_SB
#undef PG8_STAGE
#undef PG8_LDA
#undef PG8_LDB
#undef PG8_MMA
#undef PG8_WAIT_V
#undef PG8_WAIT_L
#undef PG8_BAR
#undef PG8_SCHED
}
}
#define GAS __attribute__((address_space(1)))
#define LAS __attribute__((address_space(3)))
typedef unsigned short bf16;
typedef unsigned v4u __attribute__((ext_vector_type(4)));
typedef float f32x4 __attribute__((ext_vector_type(4)));
typedef short bf16x8 __attribute__((ext_vector_type(8)));
typedef GAS unsigned gu32;
typedef GAS unsigned long long gu64;
#define RLX_AGENT __ATOMIC_RELAXED, __HIP_MEMORY_SCOPE_AGENT
#define LDS_WAIT() asm volatile("s_waitcnt lgkmcnt(0)" ::: "memory")
#define VM_WAIT() asm volatile("s_waitcnt vmcnt(0)" ::: "memory")
__device__ __forceinline__ unsigned long long rt() { return __builtin_amdgcn_s_memrealtime(); }
__device__ __forceinline__ unsigned f2bf(float f) { unsigned u = __builtin_bit_cast(unsigned, f); return (u + 0x7fffu + ((u >> 16) & 1u)) >> 16; }
__device__ __forceinline__ unsigned pk2(float lo, float hi) { return f2bf(lo) | (f2bf(hi) << 16); }

#define XB_TMO      128
#define XB_XCNT(j)  (256  + 64 * (j))
#define XB_XSUB(j)  (1280 + 64 * (j))
#define XB_XGEN(j)  (2304 + 64 * (j))
#define XB_TOP      3328
#define XB_TOPGEN   3392
#define XCD_BAR_WORDS 3456
#define XB_SPIN_CAP (1u << 18)

__device__ __forceinline__ unsigned xb_ld(unsigned* p)              { return __hip_atomic_load(p, __ATOMIC_RELAXED, __HIP_MEMORY_SCOPE_AGENT); }
__device__ __forceinline__ unsigned xb_add(unsigned* p, unsigned v) { return __hip_atomic_fetch_add(p, v, __ATOMIC_RELAXED, __HIP_MEMORY_SCOPE_AGENT); }
__device__ __forceinline__ unsigned xb_xcc_id() { return (unsigned)__builtin_amdgcn_s_getreg((3 << 11) | 20) & 0xFu; }
#define XB_SPIN(cond, bar) do { unsigned _sp = 0; while (cond) { __builtin_amdgcn_s_sleep(1); \
    if ((++_sp & 255u) == 0u) { if (xb_ld(&(bar)[XB_TMO])) break; if (_sp > XB_SPIN_CAP) { atomicAdd(&(bar)[XB_TMO], 1u); break; } } } } while (0)

struct XcdBarrier {
    unsigned* bar; unsigned x;
    volatile LAS unsigned* st;
};

__device__ __forceinline__ XcdBarrier xcd_barrier_post(unsigned* bar, volatile LAS unsigned* st) {
    XcdBarrier b; b.bar = bar; b.x = xb_xcc_id(); b.st = st;
    if (threadIdx.x == 0) (void)xb_add(&bar[XB_XCNT(b.x)], 1u);
    return b;
}
__device__ __forceinline__ void xcd_barrier_complete(unsigned* bar, unsigned x, unsigned& nloc, unsigned& nx) {
    const unsigned G = gridDim.x * gridDim.y * gridDim.z;
    unsigned sum, cnt, mine, sp = 0u;
    for (;;) {
        sum = 0u; cnt = 0u; mine = 0u;
#pragma unroll
        for (unsigned j = 0; j < 16; ++j) { const unsigned c = xb_ld(&bar[XB_XCNT(j)]); sum += c; cnt += (c > 0u) ? 1u : 0u; mine = (j == x) ? c : mine; }
        if (sum == G) break;
        __builtin_amdgcn_s_sleep(1);
        if ((++sp & 255u) == 0u) { if (xb_ld(&bar[XB_TMO])) break; if (sp > XB_SPIN_CAP) { atomicAdd(&bar[XB_TMO], 1u); break; } }
    }
    nloc = mine > 0u ? mine : 1u; nx = cnt > 0u ? cnt : 1u;
}

__device__ __forceinline__ void xcd_barrier(const XcdBarrier& b) {
    asm volatile("s_waitcnt vmcnt(0)" ::: "memory");
    __syncthreads();
    if (threadIdx.x == 0) {
        unsigned* bar = b.bar; const unsigned bx = xb_xcc_id();
        __builtin_amdgcn_s_waitcnt(0);
        unsigned nloc = b.st[0], nx = b.st[1];
        if (nloc == 0u) { xcd_barrier_complete(bar, bx, nloc, nx); b.st[0] = nloc; b.st[1] = nx; }
        const unsigned old = xb_add(&bar[XB_XSUB(bx)], 1u);
        const unsigned gen = old / nloc;
        if (old + 1u == (gen + 1u) * nloc) {
            __builtin_amdgcn_fence(__ATOMIC_RELEASE, "agent");
            asm volatile("s_waitcnt vmcnt(0)" ::: "memory");
            const unsigned og = xb_add(&bar[XB_TOP], 1u);
            const unsigned tg = og / nx;
            if (og + 1u == (tg + 1u) * nx) xb_add(&bar[XB_TOPGEN], 1u);
            else XB_SPIN(xb_ld(&bar[XB_TOPGEN]) == tg, bar);
            __builtin_amdgcn_fence(__ATOMIC_ACQUIRE, "agent");
            xb_add(&bar[XB_XGEN(bx)], 1u);
            asm volatile("s_waitcnt vmcnt(0)" ::: "memory");
        } else {
            XB_SPIN(xb_ld(&bar[XB_XGEN(bx)]) == gen, bar);
            __builtin_amdgcn_fence(__ATOMIC_ACQUIRE, "agent");
            asm volatile("s_waitcnt vmcnt(0)" ::: "memory");
        }
    }
    __syncthreads();
}


constexpr int NWAVES = 8;
constexpr int BATCH = 16, SEQ = 2048, DM = 1024, M = BATCH * SEQ;
constexpr int NIN_SRC = 5320, NIN = 5376;
constexpr float EPS = 1e-6f;
constexpr float LOG2E = 1.4426950408889634f;

constexpr size_t MiB = 1u << 20;
constexpr size_t WS_CTL = 0, CTL_ZERO_BYTES = 1 * MiB;
constexpr size_t WS_WIN = 2 * MiB;
constexpr size_t WIN_LAYER = (size_t)NIN * DM * 2;
constexpr size_t WS_WBR = 23 * MiB;
constexpr size_t WS_WOUT = 27 * MiB;
constexpr size_t WS_WSP = 31 * MiB;
constexpr size_t WS_XN = 32 * MiB;
constexpr size_t WS_YA = 32 * MiB, WS_YB = 64 * MiB;
constexpr size_t WS_Q = 96 * MiB, WS_QI = 128 * MiB;
constexpr size_t WS_T = 96 * MiB;
constexpr size_t WS_GA = 160 * MiB, WS_U = 192 * MiB, WS_VB = 224 * MiB, WS_GB = 256 * MiB;
constexpr size_t WS_MA = 288 * MiB, WS_MB = 352 * MiB;
constexpr size_t WS_K = 416 * MiB, WS_V = 420 * MiB, WS_KI = 424 * MiB, WS_WI = 428 * MiB;
constexpr size_t WS_X1B = 432 * MiB;
constexpr size_t WS_END = 496 * MiB;
constexpr size_t TILE_ELEMS = (size_t)M * 256;
constexpr int CW_BAR = 4096;
constexpr int CW_RSS = 131072;

constexpr int RING_OFF = 0, RING_BYTES = 131072;
constexpr int LDSCTL_OFF = RING_BYTES, MISC_OFF = LDSCTL_OFF + 320;
constexpr int LDS_BYTES = 163840;
constexpr int L_LIST = RING_BYTES + 1024, L_BKT = L_LIST + 8192, L_BIASB = L_BKT + 2048, L_MFIX = L_BIASB + 1024;
constexpr int L_GBAR = 143872;
constexpr int L_SCR = 144384;
static_assert(L_MFIX + 16 <= L_GBAR && L_GBAR + 256 <= L_SCR && L_SCR + 8 * 2048 <= LDS_BYTES, "selection scratch");
constexpr int L_STAT = 0, L_VN = 1024, VN_LD = 160  , L_SOUT = L_VN + 128 * VN_LD * 2, SOUT_LD = 132  ;
static_assert(L_SOUT + 128 * SOUT_LD * 4 + 1536 * 4 <= RING_BYTES && L_MFIX + 16 <= LDS_BYTES, "mixer LDS map");
constexpr int VS_LD = 80;
constexpr int KS_LD = 72;
constexpr int ATT_WAVE_BYTES = 32 * KS_LD * 2 + 32 * VS_LD * 2 + 4096 + 2048;
static_assert(ATT_WAVE_BYTES <= 16384, "a wave's attention staging fits its own two score rows");

typedef float f32x16 __attribute__((ext_vector_type(16)));
typedef short s16x4 __attribute__((ext_vector_type(4)));
typedef unsigned u32x2 __attribute__((ext_vector_type(2)));
typedef unsigned u32x4 __attribute__((ext_vector_type(4)));

__device__ __forceinline__ float bf2f(bf16 v) { return __uint_as_float((unsigned)v << 16); }
__device__ __forceinline__ float wave_sum(float v) {
#pragma unroll
    for (int o = 1; o < 64; o <<= 1) v += __shfl_xor(v, o);
    return v;
}
__device__ __forceinline__ float wave_max(float v) {
#pragma unroll
    for (int o = 1; o < 64; o <<= 1) v = fmaxf(v, __shfl_xor(v, o));
    return v;
}

__device__ __forceinline__ void p0_tr_item(const float* W, int ldw, int src_col0, int nvalid, int k0, bf16* WT, int Kd, int dst_row0, LAS float* scr, int lane, const float* kscale = nullptr) {
    const int n = lane & 31;
#pragma unroll
    for (int i = 0; i < 32; ++i) { const int kk = 2 * i + (lane >> 5); const float ks = kscale ? kscale[k0 + kk] : 1.0f; scr[kk * 33 + n] = (n < nvalid) ? W[(size_t)(k0 + kk) * ldw + src_col0 + n] * ks : 0.f; }
    LDS_WAIT(); asm volatile("" ::: "memory");
    const int c = lane & 7;
#pragma unroll
    for (int j = 0; j < 4; ++j) { const int nn = (lane >> 3) + 8 * j; const LAS float* s = scr + (8 * c) * 33 + nn;
        v4u o; o.x = pk2(s[0 * 33], s[1 * 33]); o.y = pk2(s[2 * 33], s[3 * 33]); o.z = pk2(s[4 * 33], s[5 * 33]); o.w = pk2(s[6 * 33], s[7 * 33]);
        *(GAS v4u*)(WT + (size_t)(dst_row0 + nn) * Kd + k0 + 8 * c) = o; }
    LDS_WAIT(); asm volatile("" ::: "memory");
}
__device__ __forceinline__ void win_block_src(int vb, int& src, int& nvalid) {
    const int tile = vb >> 3, j = vb & 7; nvalid = 32;
    if (tile < 2) { const int hh = j & 3, dhi = j >> 2; src = (4 * tile + hh) * 64 + 32 * dhi; }
    else if (tile == 2) { const int hh = j & 3, dhi = j >> 2;
        if (hh == 0) src = 512 + 32 * dhi; else if (hh == 1) src = 576 + 32 * dhi; else if (hh == 2) src = 1664 + 32 * dhi; else { src = 1728; nvalid = (dhi == 0) ? 8 : 0; } }
    else { const int v = vb * 32;
        if (v < 1280) src = 1152 + (v - 768); else if (v < 1792) src = 640 + (v - 1280);
        else if (v < 3328 && !(v >= 2304 && v < 2816)) { const int tl = v >> 8, t = (tl == 7) ? 0 : (tl == 8) ? 1 : (tl == 11) ? 2 : 3, w = v & 255; src = (w < 128) ? 1736 + 128 * t + w : 2760 + 128 * t + (w - 128); }
        else if (v < 2816) src = 2248 + (v - 2304);
        else { const int t = (v - 3328) >> 8, w = (v - 3328) & 255; src = (w < 128) ? 3272 + 128 * t + w : 4296 + 128 * t + (w - 128); } }
}
__device__ __forceinline__ float wave_sum_f32_dpp(float v) {
    v += __int_as_float(__builtin_amdgcn_update_dpp(0, __float_as_int(v), 0xB1, 0xf, 0xf, true));
    v += __int_as_float(__builtin_amdgcn_update_dpp(0, __float_as_int(v), 0x4E, 0xf, 0xf, true));
    v += __int_as_float(__builtin_amdgcn_update_dpp(0, __float_as_int(v), 0x141, 0xf, 0xf, true));
    v += __int_as_float(__builtin_amdgcn_update_dpp(0, __float_as_int(v), 0x140, 0xf, 0xf, true));
    return (__int_as_float(__builtin_amdgcn_readlane(__float_as_int(v), 0)) + __int_as_float(__builtin_amdgcn_readlane(__float_as_int(v), 16))) +
           (__int_as_float(__builtin_amdgcn_readlane(__float_as_int(v), 32)) + __int_as_float(__builtin_amdgcn_readlane(__float_as_int(v), 48)));
}
__device__ __forceinline__ void rms_rows2_to_bf16(const float* xrow0, const float* xrow1, const float* g, bf16* orow0, bf16* orow1, int lane) {
    const GAS f32x4* xa = (const GAS f32x4*)xrow0 + lane; const GAS f32x4* xb = (const GAS f32x4*)xrow1 + lane; const f32x4* gr = (const f32x4*)g + lane;
    f32x4 va[4], vb[4], gg[4]; float sa = 0.f, sb = 0.f;
#pragma unroll
    for (int j = 0; j < 4; ++j) { va[j] = xa[64 * j]; vb[j] = xb[64 * j]; gg[j] = gr[64 * j]; }
#pragma unroll
    for (int j = 0; j < 4; ++j) { sa += (va[j].x * va[j].x + va[j].y * va[j].y) + (va[j].z * va[j].z + va[j].w * va[j].w); sb += (vb[j].x * vb[j].x + vb[j].y * vb[j].y) + (vb[j].z * vb[j].z + vb[j].w * vb[j].w); }
    const float ra = 1.0f / sqrtf(wave_sum_f32_dpp(sa) * (1.0f / DM) + EPS), rb = 1.0f / sqrtf(wave_sum_f32_dpp(sb) * (1.0f / DM) + EPS);
    GAS unsigned long long* oa = (GAS unsigned long long*)orow0 + lane; GAS unsigned long long* ob = (GAS unsigned long long*)orow1 + lane;
#pragma unroll
    for (int j = 0; j < 4; ++j) { const f32x4 o0 = va[j] * ra * gg[j], o1 = vb[j] * rb * gg[j];
        oa[64 * j] = (unsigned long long)pk2(o0.x, o0.y) | ((unsigned long long)pk2(o0.z, o0.w) << 32);
        ob[64 * j] = (unsigned long long)pk2(o1.x, o1.y) | ((unsigned long long)pk2(o1.z, o1.w) << 32); }
}

struct Frame {
    LAS unsigned char* lds;
    int tid, lane, wave, vcu, G;
    const float *x, *norm_g, *w_in, *q_norm_g, *k_norm_g, *rel_bias, *sgu_ln_g, *sgu_ln_b, *w_spatial, *b_spatial, *w_branch, *w_out;
    float* out; unsigned char* ws;
};

__device__ __forceinline__ void p0_prologue(Frame& F0) {
    Frame F = F0; { int t = F.tid; asm volatile("" : "+v"(t)); F.tid = t; F.lane = t & 63; }
    LAS float* scr = (LAS float*)(F.lds + RING_OFF + F.wave * 16384);
    const int gw = F.vcu * NWAVES + F.wave, NGW = F.G * NWAVES;
    constexpr int I_IN = (NIN / 32) * (DM / 64);
    constexpr int I_BR = (DM / 32) * (512 / 64);
    constexpr int I_OUT = (DM / 32) * (DM / 64);
    constexpr int I_LAYER = I_IN + 2 * I_BR + I_OUT;
    for (int it = gw; it < 2 * I_LAYER; it += NGW) {
        const int l = it / I_LAYER; int r = it % I_LAYER;
        if (r < I_IN) { const int vb = r / (DM / 64), kb = r % (DM / 64); int src, nv; win_block_src(vb, src, nv);
            p0_tr_item(F.w_in + (size_t)l * DM * NIN_SRC, NIN_SRC, src, nv, 64 * kb, (bf16*)(F.ws + WS_WIN + l * WIN_LAYER), DM, 32 * vb, scr, F.lane, l ? F.norm_g + DM : nullptr); continue; }
        r -= I_IN;
        if (r < 2 * I_BR) { const int br = r / I_BR, q = r % I_BR, nb = q / 8, kb = q % 8;
            p0_tr_item(F.w_branch + (size_t)(l * 2 + br) * 512 * DM, DM, 32 * nb, 32, 64 * kb, (bf16*)(F.ws + WS_WBR + (size_t)(l * 2 + br) * MiB), 512, 32 * nb, scr, F.lane); continue; }
        r -= 2 * I_BR;
        { const int nb = r / 16, kb = r % 16;
            p0_tr_item(F.w_out + (size_t)l * DM * DM, DM, 32 * nb, 32, 64 * kb, (bf16*)(F.ws + WS_WOUT + (size_t)l * 2 * MiB), DM, 32 * nb, scr, F.lane); }
    }
    { bf16* wsp = (bf16*)(F.ws + WS_WSP);
      for (int i = (F.vcu * NWAVES * 64) + F.tid; i < 2 * 4 * 128 * 128; i += F.G * NWAVES * 64) { const int s = i & 127, t = (i >> 7) & 127; wsp[i] = (s <= t) ? (bf16)f2bf(F.w_spatial[i]) : (bf16)0; } }
    for (int m = 2 * gw; m < M; m += 2 * NGW) rms_rows2_to_bf16(F.x + (size_t)m * DM, F.x + (size_t)(m + 1) * DM, F.norm_g, (bf16*)(F.ws + WS_XN) + (size_t)m * DM, (bf16*)(F.ws + WS_XN) + (size_t)(m + 1) * DM, F.lane);
}
__device__ __forceinline__ void rms_rows2_b2b(const bf16* xrow0, const bf16* xrow1, const float* g, bf16* orow0, bf16* orow1, int lane) {
    const GAS v4u* xa = (const GAS v4u*)xrow0 + 2 * lane; const GAS v4u* xb = (const GAS v4u*)xrow1 + 2 * lane; const f32x4* gr = (const f32x4*)g + 4 * lane;
    const v4u a0 = xa[0], a1 = xa[1], b0 = xb[0], b1 = xb[1];
    f32x4 gg[4];
#pragma unroll
    for (int j = 0; j < 4; ++j) gg[j] = gr[j];
    float va[16], vb[16];
#define UNPK(dst, W_, o) dst[o] = pg8::bf_lo(W_.x); dst[o + 1] = pg8::bf_hi(W_.x); dst[o + 2] = pg8::bf_lo(W_.y); dst[o + 3] = pg8::bf_hi(W_.y); dst[o + 4] = pg8::bf_lo(W_.z); dst[o + 5] = pg8::bf_hi(W_.z); dst[o + 6] = pg8::bf_lo(W_.w); dst[o + 7] = pg8::bf_hi(W_.w);
    UNPK(va, a0, 0) UNPK(va, a1, 8) UNPK(vb, b0, 0) UNPK(vb, b1, 8)
#undef UNPK
    float sa = 0.f, sb = 0.f;
#pragma unroll
    for (int j = 0; j < 16; ++j) { sa = fmaf(va[j], va[j], sa); sb = fmaf(vb[j], vb[j], sb); }
    const float ra = 1.0f / sqrtf(wave_sum_f32_dpp(sa) * (1.0f / DM) + EPS), rb = 1.0f / sqrtf(wave_sum_f32_dpp(sb) * (1.0f / DM) + EPS);
    v4u oa[2], ob[2];
#pragma unroll
    for (int h = 0; h < 2; ++h) {
        oa[h].x = pk2(va[8 * h] * ra * gg[2 * h][0], va[8 * h + 1] * ra * gg[2 * h][1]); oa[h].y = pk2(va[8 * h + 2] * ra * gg[2 * h][2], va[8 * h + 3] * ra * gg[2 * h][3]);
        oa[h].z = pk2(va[8 * h + 4] * ra * gg[2 * h + 1][0], va[8 * h + 5] * ra * gg[2 * h + 1][1]); oa[h].w = pk2(va[8 * h + 6] * ra * gg[2 * h + 1][2], va[8 * h + 7] * ra * gg[2 * h + 1][3]);
        ob[h].x = pk2(vb[8 * h] * rb * gg[2 * h][0], vb[8 * h + 1] * rb * gg[2 * h][1]); ob[h].y = pk2(vb[8 * h + 2] * rb * gg[2 * h][2], vb[8 * h + 3] * rb * gg[2 * h][3]);
        ob[h].z = pk2(vb[8 * h + 4] * rb * gg[2 * h + 1][0], vb[8 * h + 5] * rb * gg[2 * h + 1][1]); ob[h].w = pk2(vb[8 * h + 6] * rb * gg[2 * h + 1][2], vb[8 * h + 7] * rb * gg[2 * h + 1][3]);
    }
    GAS v4u* pa = (GAS v4u*)orow0 + 2 * lane; GAS v4u* pb = (GAS v4u*)orow1 + 2 * lane;
    pa[0] = oa[0]; pa[1] = oa[1]; pb[0] = ob[0]; pb[1] = ob[1];
}
__device__ __forceinline__ void p5_renorm(Frame& F0, const bf16* xin, const float* g) {
    Frame F = F0; { int t = F.tid; asm volatile("" : "+v"(t)); F.tid = t; F.lane = t & 63; }
    const int gw = F.vcu * NWAVES + F.wave, NGW = F.G * NWAVES;
    for (int m = 2 * gw; m < M; m += 2 * NGW) rms_rows2_b2b(xin + (size_t)m * DM, xin + (size_t)(m + 1) * DM, g, (bf16*)(F.ws + WS_XN) + (size_t)m * DM, (bf16*)(F.ws + WS_XN) + (size_t)(m + 1) * DM, F.lane);
}

typedef short v4i16_t __attribute__((ext_vector_type(4)));
__device__ __forceinline__ s16x4 vtr(const LAS bf16* p) { return __builtin_bit_cast(s16x4, __builtin_amdgcn_ds_read_tr16_b64_v4i16((LAS v4i16_t*)p)); }
#ifndef REP_IDX
#define REP_IDX 1
#endif
#ifndef REP_SEL
#define REP_SEL 1
#endif
#ifndef REP_HIST
#define REP_HIST 1
#endif
#ifndef REP_EMIT
#define REP_EMIT 1
#endif
#ifndef REP_ATT
#define REP_ATT 1
#endif
#ifndef REP_SGU
#define REP_SGU 1
#endif
__device__ __forceinline__ void sgu_chunk(Frame& F, int r0, const bf16* VB, const bf16* U, const bf16* GB, const bf16* WsB, const float* bsp, const float* lng, const float* lnb, bf16* YB) {
    typedef float f32x2v __attribute__((ext_vector_type(2)));
    LAS f32x2v* stat = (LAS f32x2v*)(F.lds + L_STAT);
    LAS bf16* vn = (LAS bf16*)(F.lds + L_VN);
    LAS float* so = (LAS float*)(F.lds + L_SOUT);
    const int tid = F.tid, lane = F.lane;
    const int row = tid >> 2, q4 = tid & 3;
    LAS float* lnp = (LAS float*)(F.lds + L_SOUT + 128 * SOUT_LD * 4);
    { lnp[tid] = lng[tid]; lnp[512 + tid] = lnb[tid]; lnp[1024 + tid] = bsp[tid]; }
    {
        const v4u* p = (const v4u*)(VB + (size_t)(q4 >> 1) * TILE_ELEMS + (size_t)(r0 + row) * 256 + (q4 & 1) * 128);
        float s = 0.f, ss = 0.f;
#pragma unroll 4
        for (int i = 0; i < 16; ++i) { const v4u w = p[i];
            const float e0 = pg8::bf_lo(w.x), e1 = pg8::bf_hi(w.x), e2 = pg8::bf_lo(w.y), e3 = pg8::bf_hi(w.y), e4 = pg8::bf_lo(w.z), e5 = pg8::bf_hi(w.z), e6 = pg8::bf_lo(w.w), e7 = pg8::bf_hi(w.w);
            s += ((e0 + e1) + (e2 + e3)) + ((e4 + e5) + (e6 + e7));
            ss += ((e0 * e0 + e1 * e1) + (e2 * e2 + e3 * e3)) + ((e4 * e4 + e5 * e5) + (e6 * e6 + e7 * e7)); }
        s += __shfl_xor(s, 1); ss += __shfl_xor(ss, 1); s += __shfl_xor(s, 2); ss += __shfl_xor(ss, 2);
        const float mean = s * (1.0f / 512.0f); float var = ss * (1.0f / 512.0f) - mean * mean; var = var < 0.f ? 0.f : var;
        if (q4 == 0) stat[row] = (f32x2v){mean, 1.0f / sqrtf(var + EPS)};
    }
    __syncthreads();
    const int wv = F.wave, tt = wv >> 1, ch = wv & 1, hh = lane >> 5, cl = lane & 31;
    const int blk = (lane >> 4) & 1, tq = (lane & 15) >> 2, tp = lane & 3;
    const f32x2v st = stat[row];
    v4u vbw[4];
    {
        int cs = q4 * 32; asm volatile("" : "+v"(cs));
        const v4u* p = (const v4u*)(VB + (size_t)(r0 + row) * 256 + cs);
#pragma unroll
        for (int i = 0; i < 4; ++i) vbw[i] = p[i];
    }
    for (int g = 0; g < 4; ++g) {
        bf16x8 afr[8];
        {
            int cl_ = cl; asm volatile("" : "+v"(cl_));
            const bf16* wrow = WsB + (size_t)(g * 128 + 32 * tt + cl_) * 128 + 8 * hh;
#pragma unroll
            for (int ks = 0; ks < 8; ++ks) { const int kc = ks < 2 * tt + 2 ? ks : 2 * tt + 1; afr[ks] = *(const bf16x8*)(wrow + 16 * kc); }
        }
        v4u uwr[4], gwr[4];
        {
            int cs = q4 * 32; asm volatile("" : "+v"(cs));
            const size_t tix = (size_t)(g >> 1) * TILE_ELEMS + (size_t)(r0 + row) * 256 + (g & 1) * 128 + cs;
            const v4u* up = (const v4u*)(U + tix); const v4u* gp = (const v4u*)(GB + tix);
#pragma unroll
            for (int i = 0; i < 4; ++i) { uwr[i] = up[i]; } (void)gp; (void)gwr;
        }
        {
            int cs = q4 * 32; asm volatile("" : "+v"(cs));
            const int gn = g < 3 ? g + 1 : 3;
            const v4u* pn = (const v4u*)(VB + (size_t)(gn >> 1) * TILE_ELEMS + (size_t)(r0 + row) * 256 + (gn & 1) * 128 + cs);
            const LAS f32x4* gp = (const LAS f32x4*)(lnp + 128 * g + cs); const LAS f32x4* bp = (const LAS f32x4*)(lnp + 512 + 128 * g + cs);
#pragma unroll
            for (int i = 0; i < 4; ++i) { const v4u w = vbw[i]; vbw[i] = pn[i]; const f32x4 g0 = gp[2 * i], g1 = gp[2 * i + 1], b0 = bp[2 * i], b1 = bp[2 * i + 1];
                f32x4 x0 = (f32x4){pg8::bf_lo(w.x), pg8::bf_hi(w.x), pg8::bf_lo(w.y), pg8::bf_hi(w.y)}, x1 = (f32x4){pg8::bf_lo(w.z), pg8::bf_hi(w.z), pg8::bf_lo(w.w), pg8::bf_hi(w.w)};
                x0 = (x0 - st.x) * st.y * g0 + b0; x1 = (x1 - st.x) * st.y * g1 + b1;
                *(LAS v4u*)(vn + row * VN_LD + cs + 8 * i) = __builtin_bit_cast(v4u, pg8::pack8(x0, x1)); }
        }
        __syncthreads();
        {
            f32x16 acc[2];
#pragma unroll
            for (int nt = 0; nt < 2; ++nt)
#pragma unroll
                for (int r = 0; r < 16; ++r) acc[nt][r] = 0.f;
#pragma unroll
            for (int ks = 0; ks < 8; ++ks) if (ks < 2 * tt + 2) {
                const bf16x8 a = afr[ks];
#pragma unroll
                for (int nt = 0; nt < 2; ++nt) {
                    const LAS bf16* bp = vn + (16 * ks + 8 * hh + tq) * VN_LD + 64 * ch + 32 * nt + 16 * blk + 4 * tp;
                    const s16x4 r1 = vtr(bp), r2 = vtr(bp + 4 * VN_LD);
                    const bf16x8 bfr = (bf16x8){r1[0], r1[1], r1[2], r1[3], r2[0], r2[1], r2[2], r2[3]};
                    acc[nt] = __builtin_amdgcn_mfma_f32_32x32x16_bf16(a, bfr, acc[nt], 0, 0, 0);
                }
            }
#pragma unroll
            for (int nt = 0; nt < 2; ++nt)
#pragma unroll
                for (int r = 0; r < 16; ++r) { const int t = 32 * tt + (r & 3) + 8 * (r >> 2) + 4 * hh; so[t * SOUT_LD + 64 * ch + 32 * nt + cl] = acc[nt][r] + lnp[1024 + g * 128 + t]; }
        }
        __syncthreads();
        {
            int cs = q4 * 32; asm volatile("" : "+v"(cs));
            v4u* yp = (v4u*)(YB + (size_t)(r0 + row) * 512 + 128 * g + cs);
            const LAS f32x4* sp = (const LAS f32x4*)(so + row * SOUT_LD + cs);
#pragma unroll
            for (int i = 0; i < 4; ++i) { const v4u uw = uwr[i]; const f32x4 s0 = sp[2 * i], s1 = sp[2 * i + 1];
                f32x4 y0, y1;
                y0[0] = pg8::bf_lo(uw.x) * s0[0]; y0[1] = pg8::bf_hi(uw.x) * s0[1]; y0[2] = pg8::bf_lo(uw.y) * s0[2]; y0[3] = pg8::bf_hi(uw.y) * s0[3];
                y1[0] = pg8::bf_lo(uw.z) * s1[0]; y1[1] = pg8::bf_hi(uw.z) * s1[1]; y1[2] = pg8::bf_lo(uw.w) * s1[2]; y1[3] = pg8::bf_hi(uw.w) * s1[3];
                yp[i] = __builtin_bit_cast(v4u, pg8::pack8(y0, y1)); }
        }
    }
    __syncthreads();
}

constexpr unsigned KEY_NINF = 0x007FFFFFu;
__device__ __forceinline__ unsigned f2key(float s) { const unsigned u = __float_as_uint(s); return u ^ ((unsigned)((int)u >> 31) | 0x80000000u); }

struct AttnT { unsigned char* ws; };
#define AT_Q(A)  ((const bf16*)((A).ws + WS_Q))
#define AT_KN(A) ((const bf16*)((A).ws + WS_K))
#define AT_VV(A) ((const bf16*)((A).ws + WS_V))
#define AT_KI(A) ((const bf16*)((A).ws + WS_KI))
#define AT_QI(A) ((const bf16*)((A).ws + WS_QI))
#define AT_GA(A) ((const bf16*)((A).ws + WS_GA))
#define AT_WI(A) ((const float*)((A).ws + WS_WI))
#define AT_YA(A) ((bf16*)((A).ws + WS_YA))

struct AttPF { v4u k[4], v[4]; float bb[4]; };
struct AttCtx { const GAS char* kb; const GAS char* vb; const LAS unsigned short* lst0; const LAS unsigned char* bkt; const LAS float* biasb; int ng0, nu, g, hc, lane, tqb; };
__device__ __forceinline__ void att_prefetch(AttPF& S, const AttCtx& cx, int u_in) {
    {
        const int u = u_in < cx.nu ? u_in : cx.nu - 1;
        const int qn = (u >= cx.ng0) ? 1 : 0, bn = (u - (qn ? cx.ng0 : 0)) * 32;
        const LAS unsigned short* ln = cx.lst0 + qn * 256 + bn;
#pragma unroll
        for (int i = 0; i < 4; ++i) { const unsigned kv = ln[i * 8 + (cx.lane >> 3)] & 0x7ffu; const unsigned off = kv * 128u + (unsigned)(cx.lane & 7) * 16u;
            S.k[i] = *(const GAS v4u*)(cx.kb + off); S.v[i] = *(const GAS v4u*)(cx.vb + off); }
        const u32x2 ki = *(const LAS u32x2*)(ln + 16 * (cx.hc >> 3) + 4 * cx.g); const int t = cx.tqb + qn;
#pragma unroll
        for (int r = 0; r < 4; ++r) { const unsigned w0 = (r < 2) ? ki.x : ki.y; const unsigned bq_ = (r & 1) ? (w0 >> 27) : ((w0 >> 11) & 31u); S.bb[r] = cx.biasb[(int)bq_ * 8 + (cx.hc & 7)]; }   (void)t;
    }
}
__device__ __forceinline__ void att_stage(const AttPF& S, const AttCtx& cx, LAS bf16* Ks, LAS bf16* Vs) {
#pragma unroll
    for (int i = 0; i < 4; ++i) { *(LAS v4u*)(Ks + (i * 8 + (cx.lane >> 3)) * KS_LD + (cx.lane & 7) * 8) = S.k[i]; *(LAS v4u*)(Vs + (i * 8 + (cx.lane >> 3)) * VS_LD + (cx.lane & 7) * 8) = S.v[i]; }
}
__device__ __forceinline__ void att_compute(const AttPF& S, const AttPF& N, bool stage_next, const AttCtx& cx, int u, int qi, int grp, int n, int t, const LAS bf16x8* qs, LAS bf16* Ks, LAS bf16* Vs,
                                            const LAS unsigned char* bkt, const LAS float* biasb, float SC, f32x4 (&O)[4], float& lsum) {
    const int g = cx.g, hc = cx.hc, base = grp * 32;
    asm volatile("" ::: "memory");
    bf16x8 a0[2], a1[2], qb[2];
#pragma unroll
    for (int ks = 0; ks < 2; ++ks) { a0[ks] = *(const LAS bf16x8*)(Ks + hc * KS_LD + (g + 4 * ks) * 8); a1[ks] = *(const LAS bf16x8*)(Ks + (16 + hc) * KS_LD + (g + 4 * ks) * 8); qb[ks] = qs[64 * ks]; }
    const int tq = hc >> 2, tp = hc & 3;
    bf16x8 vb[4];
#pragma unroll
    for (int nt = 0; nt < 4; ++nt) {
        const s16x4 r1 = vtr(Vs + (4 * g + tq) * VS_LD + 16 * nt + 4 * tp), r2 = vtr(Vs + (16 + 4 * g + tq) * VS_LD + 16 * nt + 4 * tp);
        vb[nt] = (bf16x8){r1[0], r1[1], r1[2], r1[3], r2[0], r2[1], r2[2], r2[3]};
    }
    asm volatile("" ::: "memory");
    if (stage_next) att_stage(N, cx, Ks, Vs);
    asm volatile("" ::: "memory");
    f32x4 C0 = (f32x4){0.f, 0.f, 0.f, 0.f}, C1 = (f32x4){0.f, 0.f, 0.f, 0.f};
    C0 = __builtin_amdgcn_mfma_f32_16x16x32_bf16(a0[0], qb[0], C0, 0, 0, 0); C0 = __builtin_amdgcn_mfma_f32_16x16x32_bf16(a0[1], qb[1], C0, 0, 0, 0);
    C1 = __builtin_amdgcn_mfma_f32_16x16x32_bf16(a1[0], qb[0], C1, 0, 0, 0); C1 = __builtin_amdgcn_mfma_f32_16x16x32_bf16(a1[1], qb[1], C1, 0, 0, 0);
    const int sub = hc >> 3;
    float P[4];
#pragma unroll
    for (int r = 0; r < 4; ++r) {
        const float cx_ = __int_as_float(__builtin_amdgcn_update_dpp(__float_as_int(C0[r]), __float_as_int(C1[r]), 0x118, 0xf, 0xC, false));
        P[r] = __builtin_amdgcn_exp2f(fmaf(cx_, SC, S.bb[r]));
    }
    if (base + 32 > n) {
#pragma unroll
        for (int r = 0; r < 4; ++r) P[r] = (base + 16 * sub + 4 * g + r < n) ? P[r] : 0.f;
    }
    lsum += (P[0] + P[1]) + (P[2] + P[3]);
    u32x4 pw; pw.x = pg8::cvt_pk_bf16(P[0], P[1]); pw.y = pg8::cvt_pk_bf16(P[2], P[3]);
    pw.z = (unsigned)__builtin_amdgcn_update_dpp(0, (int)pw.x, 0x108, 0xf, 0xf, true); pw.w = (unsigned)__builtin_amdgcn_update_dpp(0, (int)pw.y, 0x108, 0xf, 0xf, true);
    const bf16x8 pf = __builtin_bit_cast(bf16x8, pw);
#pragma unroll
    for (int nt = 0; nt < 4; ++nt) O[nt] = __builtin_amdgcn_mfma_f32_16x16x32_bf16(pf, vb[nt], O[nt], 0, 0, 0);
}
template <bool PF>
__device__ __forceinline__ void att_step(AttPF& S, const AttPF& N, const AttCtx& cx, int u, int grp, int n, const bf16x8 (&qb)[2], LAS bf16* Ks, LAS bf16* Vs, float SC, f32x4 (&O)[4], float& lsum) {
    const int g = cx.g, hc = cx.hc, base = grp * 32;
    asm volatile("" ::: "memory");
    unsigned kv[4] = {0u, 0u, 0u, 0u}; u32x2 ki = (u32x2){0u, 0u}; int tn = 0;
    if (PF) {
        const int un = (u + 3 < cx.nu) ? u + 3 : cx.nu - 1;
        const int qn = (un >= cx.ng0) ? 1 : 0, bn = (un - (qn ? cx.ng0 : 0)) * 32;
        const LAS unsigned short* ln = cx.lst0 + qn * 256 + bn;
#pragma unroll
        for (int i = 0; i < 4; ++i) kv[i] = ln[i * 8 + (cx.lane >> 3)];
        ki = *(const LAS u32x2*)(ln + 16 * (hc >> 3) + 4 * g);
        tn = cx.tqb + qn;
    }
    asm volatile("" ::: "memory");
    bf16x8 a0[2], a1[2];
#pragma unroll
    for (int ks = 0; ks < 2; ++ks) { a0[ks] = *(const LAS bf16x8*)(Ks + hc * KS_LD + (g + 4 * ks) * 8); a1[ks] = *(const LAS bf16x8*)(Ks + (16 + hc) * KS_LD + (g + 4 * ks) * 8); }
    const int tq = hc >> 2, tp = hc & 3;
    bf16x8 vb[4];
#pragma unroll
    for (int nt = 0; nt < 4; ++nt) {
        const s16x4 r1 = vtr(Vs + (4 * g + tq) * VS_LD + 16 * nt + 4 * tp), r2 = vtr(Vs + (16 + 4 * g + tq) * VS_LD + 16 * nt + 4 * tp);
        vb[nt] = (bf16x8){r1[0], r1[1], r1[2], r1[3], r2[0], r2[1], r2[2], r2[3]};
    }
    asm volatile("" ::: "memory");
    att_stage(N, cx, Ks, Vs);
    asm volatile("" ::: "memory");
    unsigned bq[4] = {0u, 0u, 0u, 0u};
    if (PF) {
#pragma unroll
        for (int i = 0; i < 4; ++i) { const unsigned off = (kv[i] & 0x7ffu) * 128u + (unsigned)(cx.lane & 7) * 16u; S.k[i] = *(const GAS v4u*)(cx.kb + off); S.v[i] = *(const GAS v4u*)(cx.vb + off); }
        bq[0] = (ki.x >> 11) & 31u; bq[1] = ki.x >> 27; bq[2] = (ki.y >> 11) & 31u; bq[3] = ki.y >> 27;
    }
    asm volatile("" ::: "memory");
    f32x4 C0 = (f32x4){0.f, 0.f, 0.f, 0.f}, C1 = (f32x4){0.f, 0.f, 0.f, 0.f};
    C0 = __builtin_amdgcn_mfma_f32_16x16x32_bf16(a0[0], qb[0], C0, 0, 0, 0); C1 = __builtin_amdgcn_mfma_f32_16x16x32_bf16(a1[0], qb[0], C1, 0, 0, 0);
    C0 = __builtin_amdgcn_mfma_f32_16x16x32_bf16(a0[1], qb[1], C0, 0, 0, 0); C1 = __builtin_amdgcn_mfma_f32_16x16x32_bf16(a1[1], qb[1], C1, 0, 0, 0);
    float bbn[4] = {0.f, 0.f, 0.f, 0.f};
    if (PF) {
#pragma unroll
        for (int r = 0; r < 4; ++r) bbn[r] = cx.biasb[(int)bq[r] * 8 + (hc & 7)];
    }
    asm volatile("" ::: "memory");
    const int sub = hc >> 3;
    float P[4];
#pragma unroll
    for (int r = 0; r < 4; ++r) {
        const float cx_ = __int_as_float(__builtin_amdgcn_update_dpp(__float_as_int(C0[r]), __float_as_int(C1[r]), 0x118, 0xf, 0xC, false));
        P[r] = __builtin_amdgcn_exp2f(fmaf(cx_, SC, S.bb[r]));
    }
    if (base + 32 > n) {
#pragma unroll
        for (int r = 0; r < 4; ++r) P[r] = (base + 16 * sub + 4 * g + r < n) ? P[r] : 0.f;
    }
    lsum += (P[0] + P[1]) + (P[2] + P[3]);
    u32x4 pw; pw.x = pg8::cvt_pk_bf16(P[0], P[1]); pw.y = pg8::cvt_pk_bf16(P[2], P[3]);
    pw.z = (unsigned)__builtin_amdgcn_update_dpp(0, (int)pw.x, 0x108, 0xf, 0xf, true); pw.w = (unsigned)__builtin_amdgcn_update_dpp(0, (int)pw.y, 0x108, 0xf, 0xf, true);
    const bf16x8 pf = __builtin_bit_cast(bf16x8, pw);
#pragma unroll
    for (int nt = 0; nt < 4; ++nt) O[nt] = __builtin_amdgcn_mfma_f32_16x16x32_bf16(pf, vb[nt], O[nt], 0, 0, 0);
    if (PF) {
#pragma unroll
        for (int r = 0; r < 4; ++r) S.bb[r] = bbn[r];
    }
}
__device__ __forceinline__ void att_finish(const AttnT& A, size_t qrow, const LAS bf16* gs, int g, int hc, f32x4 (&O)[4], float& lsum) {
    lsum += __int_as_float(__builtin_amdgcn_update_dpp(0, __float_as_int(lsum), 0x128, 0xf, 0xf, true));
    { const unsigned xi = __float_as_uint(lsum); const auto s16 = __builtin_amdgcn_permlane16_swap(xi, xi, false, false); lsum = __uint_as_float(s16[0]) + __uint_as_float(s16[1]); }
    { const unsigned xi = __float_as_uint(lsum); const auto s32 = __builtin_amdgcn_permlane32_swap(xi, xi, false, false); lsum = __uint_as_float(s32[0]) + __uint_as_float(s32[1]); }
    const int rinv = __float_as_int(lsum > 0.f ? __builtin_amdgcn_rcpf(lsum) : 0.f);
    float linv[4];
#pragma unroll
    for (int r = 0; r < 4; ++r) { const float lo = __int_as_float(__builtin_amdgcn_readlane(rinv, r)), hi = __int_as_float(__builtin_amdgcn_readlane(rinv, 4 + r)); linv[r] = (g == 1) ? hi : lo; }
    if (g < 2) {
#pragma unroll
        for (int r = 0; r < 4; ++r)
#pragma unroll
            for (int nt = 0; nt < 4; ++nt) { const size_t idx = qrow * 512 + (4 * g + r) * 64 + 16 * nt + hc;
                AT_YA(A)[idx] = (bf16)f2bf(O[nt][r] * linv[r] * bf2f(gs[(4 * g + r) * 64 + 16 * nt + hc])); }
    }
#pragma unroll
    for (int nt = 0; nt < 4; ++nt) O[nt] = (f32x4){0.f, 0.f, 0.f, 0.f};
    lsum = 0.f;
}
__device__ __forceinline__ unsigned wave_sum_u32(unsigned v) {
    v += (unsigned)__builtin_amdgcn_update_dpp(0, (int)v, 0xB1, 0xf, 0xf, true);
    v += (unsigned)__builtin_amdgcn_update_dpp(0, (int)v, 0x4E, 0xf, 0xf, true);
    v += (unsigned)__builtin_amdgcn_update_dpp(0, (int)v, 0x141, 0xf, 0xf, true);
    v += (unsigned)__builtin_amdgcn_update_dpp(0, (int)v, 0x140, 0xf, 0xf, true);
    return (unsigned)__builtin_amdgcn_readlane((int)v, 0) + (unsigned)__builtin_amdgcn_readlane((int)v, 16) + (unsigned)__builtin_amdgcn_readlane((int)v, 32) + (unsigned)__builtin_amdgcn_readlane((int)v, 48);
}
__device__ __forceinline__ int wave_max_i32(int v) {
    v = max(v, __builtin_amdgcn_update_dpp(v, v, 0xB1, 0xf, 0xf, false)); v = max(v, __builtin_amdgcn_update_dpp(v, v, 0x4E, 0xf, 0xf, false));
    v = max(v, __builtin_amdgcn_update_dpp(v, v, 0x141, 0xf, 0xf, false)); v = max(v, __builtin_amdgcn_update_dpp(v, v, 0x140, 0xf, 0xf, false));
    return max(max(__builtin_amdgcn_readlane(v, 0), __builtin_amdgcn_readlane(v, 16)), max(__builtin_amdgcn_readlane(v, 32), __builtin_amdgcn_readlane(v, 48)));
}
__device__ __forceinline__ unsigned lanes_below(unsigned long long m) { return __builtin_amdgcn_mbcnt_hi((unsigned)(m >> 32), __builtin_amdgcn_mbcnt_lo((unsigned)m, 0u)); }
__device__ __forceinline__ void select_bisect(const float (&s)[32], float& Ts, unsigned& tieneed) {
    unsigned Tk = 0u; bool done = false;
    for (int bit = 31; bit >= 0; --bit) {
        const unsigned cand = Tk | (1u << bit);
        unsigned c = 0u;
#pragma unroll
        for (int i = 0; i < 32; ++i) c += (f2key(s[i]) >= cand) ? 1u : 0u;
        c = wave_sum_u32(c);
        if (c >= 256u) Tk = cand;
        if (c == 256u) { done = true; break; }
    }
    unsigned kmin = 0xffffffffu; unsigned cgt = 0u;
#pragma unroll
    for (int i = 0; i < 32; ++i) { const unsigned k = f2key(s[i]); kmin = (k >= Tk && k < kmin) ? k : kmin; }
    kmin = ~(unsigned)wave_max_i32((int)(~kmin ^ 0x80000000u)) ^ 0x80000000u;
#pragma unroll
    for (int i = 0; i < 32; ++i) cgt += (f2key(s[i]) > kmin) ? 1u : 0u;
    cgt = wave_sum_u32(cgt);
    const unsigned u = (kmin & 0x80000000u) ? (kmin ^ 0x80000000u) : ~kmin;
    Ts = __uint_as_float(u); tieneed = 256u - cgt; (void)done;
}
__device__ __forceinline__ bool select_hist(const float (&s)[32], const int kmax, LAS unsigned char* scr, const int lane, float& Ts, unsigned& tieneed) {
    int mxi = (int)0x80000000;
#pragma unroll
    for (int i = 0; i < 32; ++i) mxi = max(mxi, __float_as_int(s[i]));
    const float mx = __int_as_float(wave_max_i32(mxi));
    if (!(mx > 0.f && mx < 1e30f)) return false;
    const float inv = 128.0f * __builtin_amdgcn_rcpf(mx);
    LAS unsigned* hist = (LAS unsigned*)scr;
    LAS float* candS = (LAS float*)(scr + 1024);
    *(LAS v4u*)(hist + 4 * lane) = (v4u){0u, 0u, 0u, 0u};
    asm volatile("" ::: "memory");
#pragma unroll
    for (int gi = 0; gi < 4; ++gi) {
        if (512 * gi < kmax) {
#pragma unroll
            for (int i = 8 * gi; i < 8 * gi + 8; ++i) { const int b = (int)__builtin_amdgcn_fmed3f(fmaf(s[i], inv, 128.0f), 0.0f, 255.0f);
                if (64 * i + lane < kmax) __hip_atomic_fetch_add(hist + b, 1u, __ATOMIC_RELAXED, __HIP_MEMORY_SCOPE_WORKGROUP); }
        }
    }
    asm volatile("" ::: "memory");
    const v4u hv = *(const LAS v4u*)(hist + 252 - 4 * lane);
    const unsigned v = (hv.x + hv.y) + (hv.z + hv.w);
    unsigned x = v;
    x += (unsigned)__builtin_amdgcn_update_dpp(0, (int)x, 0x111, 0xf, 0xf, true);
    x += (unsigned)__builtin_amdgcn_update_dpp(0, (int)x, 0x112, 0xf, 0xf, true);
    x += (unsigned)__builtin_amdgcn_update_dpp(0, (int)x, 0x114, 0xf, 0xf, true);
    x += (unsigned)__builtin_amdgcn_update_dpp(0, (int)x, 0x118, 0xf, 0xf, true);
    const unsigned r0 = (unsigned)__builtin_amdgcn_readlane((int)x, 15), r1 = (unsigned)__builtin_amdgcn_readlane((int)x, 31), r2 = (unsigned)__builtin_amdgcn_readlane((int)x, 47);
    const int row = lane >> 4;
    x += (row >= 1 ? r0 : 0u) + (row >= 2 ? r1 : 0u) + (row >= 3 ? r2 : 0u);
    const unsigned long long mge = __ballot(x >= 256u);
    if (mge == 0ull) return false;
    const int L = (int)__builtin_ctzll(mge);
    unsigned above = (unsigned)__builtin_amdgcn_readlane((int)(x - v), L);
    const unsigned h3 = (unsigned)__builtin_amdgcn_readlane((int)hv.w, L), h2 = (unsigned)__builtin_amdgcn_readlane((int)hv.z, L), h1 = (unsigned)__builtin_amdgcn_readlane((int)hv.y, L), h0 = (unsigned)__builtin_amdgcn_readlane((int)hv.x, L);
    int B; unsigned inB;
    if (above + h3 >= 256u) { B = 255 - 4 * L; inB = h3; }
    else { above += h3;
        if (above + h2 >= 256u) { B = 254 - 4 * L; inB = h2; }
        else { above += h2;
            if (above + h1 >= 256u) { B = 253 - 4 * L; inB = h1; }
            else { above += h1; B = 252 - 4 * L; inB = h0; } } }
    if (inB > 64u || B == 0) return false;
    unsigned cb = 0u;
#pragma unroll
    for (int gi = 0; gi < 4; ++gi) {
        if (512 * gi < kmax) {
#pragma unroll
            for (int i = 8 * gi; i < 8 * gi + 8; ++i) {
                const int b = (int)__builtin_amdgcn_fmed3f(fmaf(s[i], inv, 128.0f), 0.0f, 255.0f);
                const bool eq = (b == B);
                const unsigned long long me = __ballot(eq);
                candS[eq ? (cb + lanes_below(me)) : (64u + lane)] = s[i];
                cb += (unsigned)__popcll(me);
            }
        }
    }
    asm volatile("" ::: "memory");
    const float c = (lane < (int)inB) ? candS[lane] : -INFINITY;
    unsigned rank = 0u;
    for (int j = 0; j < (int)inB; ++j) { const float cj = __int_as_float(__builtin_amdgcn_readlane(__float_as_int(c), j)); rank += ((cj > c) || (cj == c && j < lane)) ? 1u : 0u; }
    const unsigned need = 256u - above;
    const unsigned long long mt = __ballot(lane < (int)inB && rank == need - 1u);
    if (mt == 0ull) return false;
    const int lt = (int)__builtin_ctzll(mt);
    Ts = __int_as_float(__builtin_amdgcn_readlane(__float_as_int(c), lt));
    tieneed = (unsigned)__popcll(__ballot(lane < (int)inB && c == Ts && rank < need));
    if (tieneed == (unsigned)__popcll(__ballot(lane < (int)inB && c == Ts))) tieneed = 4096u;
    return true;
}
__device__ __forceinline__ unsigned select_emit(const float (&s)[32], const int kmax, const float Ts, const unsigned tieneed, LAS unsigned short* lst, LAS unsigned short* dump, const int lane) {
    unsigned n = 0u;
    const int dofs = (int)(dump - lst) + lane;
    if (tieneed >= 4096u) {
#pragma unroll
        for (int gi = 0; gi < 4; ++gi) {
            if (512 * gi < kmax) {
#pragma unroll
                for (int i = 8 * gi; i < 8 * gi + 8; ++i) {
                    const bool sel = s[i] >= Ts;
                    const unsigned long long ms = __ballot(sel);
                    const unsigned pos = n + lanes_below(ms);
                    lst[(sel && pos < 256u) ? (int)pos : dofs] = (unsigned short)(64 * i + lane);
                    n += (unsigned)__popcll(ms);
                }
            }
        }
    } else {
        unsigned tb = 0u;
#pragma unroll
        for (int gi = 0; gi < 4; ++gi) {
            if (512 * gi < kmax) {
#pragma unroll
                for (int i = 8 * gi; i < 8 * gi + 8; ++i) {
                    const bool eq = s[i] == Ts, gt = s[i] > Ts;
                    const unsigned long long me = __ballot(eq);
                    const bool sel = gt || (eq && tb + lanes_below(me) < tieneed); tb += (unsigned)__popcll(me);
                    const unsigned long long ms = __ballot(sel);
                    const unsigned pos = n + lanes_below(ms);
                    lst[(sel && pos < 256u) ? (int)pos : dofs] = (unsigned short)(64 * i + lane);
                    n += (unsigned)__popcll(ms);
                }
            }
        }
    }
    n = n > 256u ? 256u : n;
    lst[(lane < 32 && n + lane < 256u) ? (int)(n + lane) : dofs] = 0;
    return n;
}

__device__ __forceinline__ unsigned select_emit_scan(const float (&s)[32], const int kmax, const float Ts, LAS unsigned short* lst, LAS unsigned short* dump, const int lane) {
    unsigned mask = 0u;
#pragma unroll
    for (int gi = 0; gi < 4; ++gi) {
        if (512 * gi < kmax) {
#pragma unroll
            for (int i = 8 * gi; i < 8 * gi + 8; ++i) mask = (mask << 1) | ((s[i] >= Ts) ? 1u : 0u);
        } else mask <<= 8;
    }
    const unsigned cnt = (unsigned)__popc(mask);
    unsigned x = cnt;
    x += (unsigned)__builtin_amdgcn_update_dpp(0, (int)x, 0x111, 0xf, 0xf, true);
    x += (unsigned)__builtin_amdgcn_update_dpp(0, (int)x, 0x112, 0xf, 0xf, true);
    x += (unsigned)__builtin_amdgcn_update_dpp(0, (int)x, 0x114, 0xf, 0xf, true);
    x += (unsigned)__builtin_amdgcn_update_dpp(0, (int)x, 0x118, 0xf, 0xf, true);
    const unsigned r0 = (unsigned)__builtin_amdgcn_readlane((int)x, 15), r1 = (unsigned)__builtin_amdgcn_readlane((int)x, 31), r2 = (unsigned)__builtin_amdgcn_readlane((int)x, 47), r3 = (unsigned)__builtin_amdgcn_readlane((int)x, 63);
    const int row = lane >> 4;
    x += (row >= 1 ? r0 : 0u) + (row >= 2 ? r1 : 0u) + (row >= 3 ? r2 : 0u);
    unsigned n = ((r0 + r1) + (r2 + r3));
    const unsigned base = x - cnt;
    const int maxc = wave_max_i32((int)cnt);
    const int dofs = (int)(dump - lst) + lane;
    unsigned mk = mask;
    for (int k = 0; k < maxc; ++k) {
        const int i = __builtin_clz(mk | 1u);
        const bool ok = (unsigned)k < cnt && base + (unsigned)k < 256u;
        lst[ok ? (int)(base + (unsigned)k) : dofs] = (unsigned short)(64 * i + lane);
        mk &= ~(0x80000000u >> i);
    }
    n = n > 256u ? 256u : n;
    lst[(lane < 32 && n + lane < 256u) ? (int)(n + lane) : dofs] = 0;
    return n;
}

__device__ __forceinline__ unsigned lane_prefix_incl(unsigned v, const int lane, unsigned& tot) {
    unsigned x = v;
    x += (unsigned)__builtin_amdgcn_update_dpp(0, (int)x, 0x111, 0xf, 0xf, true);
    x += (unsigned)__builtin_amdgcn_update_dpp(0, (int)x, 0x112, 0xf, 0xf, true);
    x += (unsigned)__builtin_amdgcn_update_dpp(0, (int)x, 0x114, 0xf, 0xf, true);
    x += (unsigned)__builtin_amdgcn_update_dpp(0, (int)x, 0x118, 0xf, 0xf, true);
    const unsigned r0 = (unsigned)__builtin_amdgcn_readlane((int)x, 15), r1 = (unsigned)__builtin_amdgcn_readlane((int)x, 31), r2 = (unsigned)__builtin_amdgcn_readlane((int)x, 47), r3 = (unsigned)__builtin_amdgcn_readlane((int)x, 63);
    const int row = lane >> 4;
    x += (row >= 1 ? r0 : 0u) + (row >= 2 ? r1 : 0u) + (row >= 3 ? r2 : 0u);
    tot = (r0 + r1) + (r2 + r3);
    return x;
}
__device__ __forceinline__ float vmax_raw(float a, float b) { float r; asm("v_max_f32 %0, %1, %2" : "=v"(r) : "v"(a), "v"(b)); return r; }
__device__ __forceinline__ float wave_max_f32(float v) {
    v = vmax_raw(v, __int_as_float(__builtin_amdgcn_update_dpp(__float_as_int(v), __float_as_int(v), 0xB1, 0xf, 0xf, false))); v = vmax_raw(v, __int_as_float(__builtin_amdgcn_update_dpp(__float_as_int(v), __float_as_int(v), 0x4E, 0xf, 0xf, false)));
    v = vmax_raw(v, __int_as_float(__builtin_amdgcn_update_dpp(__float_as_int(v), __float_as_int(v), 0x141, 0xf, 0xf, false))); v = vmax_raw(v, __int_as_float(__builtin_amdgcn_update_dpp(__float_as_int(v), __float_as_int(v), 0x140, 0xf, 0xf, false)));
    const int a = __float_as_int(v);
    return fmaxf(fmaxf(__int_as_float(__builtin_amdgcn_readlane(a, 0)), __int_as_float(__builtin_amdgcn_readlane(a, 16))), fmaxf(__int_as_float(__builtin_amdgcn_readlane(a, 32)), __int_as_float(__builtin_amdgcn_readlane(a, 48))));
}
#define CLS_BIT(m, f, th) asm("v_cmp_ge_f32 vcc, %1, %2\n\tv_addc_co_u32 %0, vcc, %0, %0, vcc" : "+v"(m) : "v"(f), "v"(th) : "vcc")
__device__ __forceinline__ bool hist_boundary(const LAS unsigned* hist, const int lane, const unsigned above0, int& B, unsigned& above, unsigned& inB) {
    v4u hv = *(const LAS v4u*)(hist + 252 - 4 * lane);
    { const v4u hw = *(const LAS v4u*)(hist + 256 + 252 - 4 * lane); hv.x += hw.x; hv.y += hw.y; hv.z += hw.z; hv.w += hw.w; }
    const unsigned v = (hv.x + hv.y) + (hv.z + hv.w);
    unsigned tot;
    const unsigned x = lane_prefix_incl(v, lane, tot) + above0;
    const unsigned long long mge = __ballot(x >= 256u);
    if (mge == 0ull) return false;
    const int L = (int)__builtin_ctzll(mge);
    above = (unsigned)__builtin_amdgcn_readlane((int)(x - v), L);
    const unsigned h3 = (unsigned)__builtin_amdgcn_readlane((int)hv.w, L), h2 = (unsigned)__builtin_amdgcn_readlane((int)hv.z, L), h1 = (unsigned)__builtin_amdgcn_readlane((int)hv.y, L), h0 = (unsigned)__builtin_amdgcn_readlane((int)hv.x, L);
    if (above + h3 >= 256u) { B = 255 - 4 * L; inB = h3; }
    else { above += h3;
        if (above + h2 >= 256u) { B = 254 - 4 * L; inB = h2; }
        else { above += h2;
            if (above + h1 >= 256u) { B = 253 - 4 * L; inB = h1; }
            else { above += h1; B = 252 - 4 * L; inB = h0; } } }
    return true;
}
#ifndef REP_FB
#define REP_FB 1
#endif
#ifndef REP_FC
#define REP_FC 1
#endif
#ifndef REP_FE
#define REP_FE 1
#endif
#define SEL_FOR_FULL(...) \
    _Pragma("unroll") for (int gi = 0; gi < 4; ++gi) { \
        if (8 * (gi + 1) <= nfull) { _Pragma("unroll") for (int i = 8 * gi; i < 8 * gi + 8; ++i) { __VA_ARGS__ } } \
        else if (8 * gi < nfull) { _Pragma("unroll") for (int i = 8 * gi; i < 8 * gi + 8; ++i) { if (i < nfull) { __VA_ARGS__ } } } }
__device__ __forceinline__ unsigned select_fused(const float (&s)[32], const int klim_in, const LAS unsigned* srow, LAS unsigned char* scr, const int lane, LAS unsigned short* lst) {
    const unsigned FAIL = 0xffffffffu;
    const int klim = __builtin_amdgcn_readfirstlane(klim_in);
    const int nfull = klim >> 6, prem = klim & 63, ip = nfull < 31 ? nfull : 31;
    const bool pv = lane < prem;
    const float sp = pv ? __uint_as_float(srow[64 * ip]) : -INFINITY;
    float mxl = sp, mnl = pv ? sp : INFINITY;
    SEL_FOR_FULL( mxl = fmaxf(mxl, s[i]); mnl = fminf(mnl, s[i]); )
    const float mx = wave_max_f32(mxl), mn = -wave_max_f32(-mnl);
    const float range = mx - mn;
    if (!(range > 0.f && range < 1e30f)) return FAIL;
    const float inv = 255.0f * __builtin_amdgcn_rcpf(range);
    const float c0 = fmaf(-mn, inv, 0.5f);
    const float fp = fmaf(sp, inv, c0);
    LAS unsigned* hist = (LAS unsigned*)scr;
    LAS unsigned* hb = hist + 256 * (lane & 1);
    LAS float* candS = (LAS float*)lst;
    LAS unsigned short* dump = (LAS unsigned short*)scr;
    int B; unsigned above, inB;
    for (int rfb = 0; rfb < REP_FB; ++rfb) {
    asm volatile("" ::: "memory");
    *(LAS v4u*)(hist + 4 * lane) = (v4u){0u, 0u, 0u, 0u}; *(LAS v4u*)(hist + 256 + 4 * lane) = (v4u){0u, 0u, 0u, 0u};
    asm volatile("" ::: "memory");
    SEL_FOR_FULL( const int b = (int)__builtin_amdgcn_fmed3f(fmaf(s[i], inv, c0), 0.0f, 255.0f); __hip_atomic_fetch_add(hb + b, 1u, __ATOMIC_RELAXED, __HIP_MEMORY_SCOPE_WORKGROUP); )
    if (pv) { const int b = (int)__builtin_amdgcn_fmed3f(fp, 0.0f, 255.0f); __hip_atomic_fetch_add(hb + b, 1u, __ATOMIC_RELAXED, __HIP_MEMORY_SCOPE_WORKGROUP); }
    asm volatile("" ::: "memory");
    if (!hist_boundary(hist, lane, 0u, B, above, inB)) return FAIL;
    }
    float thge = (float)B, thgt = (float)(B + 1);
    if (B == 0) thge = -1.0f;
    if (B == 255) thgt = 1024.0f;
    if (inB > 64u) {
        const float fB = (float)B, c1 = -256.0f * fB;
        asm volatile("" ::: "memory");
        *(LAS v4u*)(hist + 4 * lane) = (v4u){0u, 0u, 0u, 0u}; *(LAS v4u*)(hist + 256 + 4 * lane) = (v4u){0u, 0u, 0u, 0u};
        asm volatile("" ::: "memory");
        SEL_FOR_FULL( const float f = fmaf(s[i], inv, c0); const int b = (int)__builtin_amdgcn_fmed3f(fmaf(f, 256.0f, c1), 0.0f, 255.0f);
                      if (f >= thge && f < thgt) __hip_atomic_fetch_add(hb + b, 1u, __ATOMIC_RELAXED, __HIP_MEMORY_SCOPE_WORKGROUP); )
        { const int b = (int)__builtin_amdgcn_fmed3f(fmaf(fp, 256.0f, c1), 0.0f, 255.0f); if (fp >= thge && fp < thgt) __hip_atomic_fetch_add(hb + b, 1u, __ATOMIC_RELAXED, __HIP_MEMORY_SCOPE_WORKGROUP); }
        asm volatile("" ::: "memory");
        int B2; unsigned above2, inB2;
        if (!hist_boundary(hist, lane, above, B2, above2, inB2)) return FAIL;
        if (inB2 > 64u) return FAIL;
        above = above2; inB = inB2;
        if (B2 > 0) thge = fB + (float)B2 * 0.00390625f;
        if (B2 < 255) thgt = fB + (float)(B2 + 1) * 0.00390625f;
    }
    unsigned mgt = 0u, mgeq = 0u;
    for (int rfc = 0; rfc < REP_FC; ++rfc) { mgt = 0u; mgeq = 0u; asm volatile("" : "+v"(thge), "+v"(thgt));
    SEL_FOR_FULL( const float f = fmaf(s[i], inv, c0); CLS_BIT(mgt, f, thgt); CLS_BIT(mgeq, f, thge); )
    }
    { const int sh = (32 - nfull) & 31; if (nfull < 32) { mgt <<= sh; mgeq <<= sh; }
      const unsigned bitp = 0x80000000u >> ip; mgt |= (fp >= thgt) ? bitp : 0u; mgeq |= (fp >= thge) ? bitp : 0u; }
    const unsigned meq = mgeq & ~mgt;
    const unsigned cnte = (unsigned)__popc(meq);
    unsigned tote;
    const unsigned ebase = lane_prefix_incl(cnte, lane, tote) - cnte;
    if (tote != inB) return FAIL;
    const int maxe = wave_max_i32((int)cnte);
    float cv0 = -INFINITY, cv1 = -INFINITY; unsigned cb0 = 0u, cb1 = 0u;
    {
        unsigned mk = meq;
        for (int k = 0; k < maxe; ++k) {
            const int i = __builtin_clz(mk | 1u);
            const float sv = __uint_as_float(srow[64 * i]);
            const bool okk = (unsigned)k < cnte;
            const unsigned bit = 0x80000000u >> i;
            candS[okk ? (int)(ebase + (unsigned)k) : (64 + lane)] = sv;
            if (k == 0) { cv0 = okk ? sv : -INFINITY; cb0 = bit; }
            if (k == 1) { cv1 = okk ? sv : -INFINITY; cb1 = bit; }
            mk &= ~bit;
        }
    }
    asm volatile("" ::: "memory");
    const bool cvalid = lane < (int)inB;
    const float c = cvalid ? candS[lane] : -INFINITY;
    unsigned rgt = 0u;
    for (int j = 0; j < (int)inB; ++j) { const float cj = __int_as_float(__builtin_amdgcn_readlane(__float_as_int(c), j)); rgt += (cj > c) ? 1u : 0u; }
    const unsigned need = 256u - above;
    const float Ts = -wave_max_f32((cvalid && rgt < need) ? -c : -INFINITY);
    if (!(Ts > -INFINITY)) return FAIL;
    if ((unsigned)__popcll(__ballot(cvalid && c >= Ts)) != need) return FAIL;
    unsigned msel = mgt | ((cv0 >= Ts) ? cb0 : 0u) | ((cv1 >= Ts) ? cb1 : 0u);
    if (maxe > 2) {
        unsigned mk = meq & ~(cb0 | cb1);
        for (int k = 2; k < maxe; ++k) {
            const int i = __builtin_clz(mk | 1u);
            const float sv = __uint_as_float(srow[64 * i]);
            const unsigned bit = 0x80000000u >> i;
            msel |= ((unsigned)k < cnte && sv >= Ts) ? bit : 0u;
            mk &= ~bit;
        }
    }
    unsigned n;
    for (int rfe = 0; rfe < REP_FE; ++rfe) {
    asm volatile("" : "+v"(msel));
    const unsigned cnt = (unsigned)__popc(msel);
    const unsigned base = lane_prefix_incl(cnt, lane, n) - cnt;
    if (n > 256u) return FAIL;
    const int dofs = (int)(dump - lst) + lane;
    {
        unsigned mk = msel;
        LAS unsigned short* wp = lst + base;
        while (mk != 0u) {
            const int i = __builtin_clz(mk);
            *wp++ = (unsigned short)(64 * i + lane);
            mk &= ~(0x80000000u >> i);
        }
    }
    n = n > 256u ? 256u : n;
    lst[(lane < 32 && n + lane < 256u) ? (int)(n + lane) : dofs] = 0;
    }
    return n;
}

constexpr int GW = 2, NRT = GW / 2, GQ = 2 * GW;
constexpr int RD = 4;
struct SweepOps { bf16x8 aq[NRT][4]; float wA[NRT][8], wB[NRT][8]; bf16x8 bt[RD][4]; };
__device__ __forceinline__ void sweep_load(SweepOps& P, const AttnT& A, const int b, const int t0, const int wg, const int lane_in) {
    int lane = lane_in; asm volatile("" : "+v"(lane));
    const size_t rb = (size_t)b * SEQ;
    const int H = lane >> 5, c = lane & 31, tmaxI = (t0 + GQ - 1) >> 5;
    const int ql = (c >> 4) + 2 * ((c >> 2) & 1), hd = (c & 3) + 4 * ((c >> 3) & 1);
#pragma unroll
    for (int rt = 0; rt < NRT; ++rt) {
        const GAS bf16* qp = (const GAS bf16*)(AT_QI(A) + (size_t)(hd >> 2) * TILE_ELEMS + (rb + t0 + 4 * rt + ql) * 256 + (hd & 3) * 64 + 8 * H);
#pragma unroll
        for (int ks = 0; ks < 4; ++ks) P.aq[rt][ks] = *(const GAS bf16x8*)(qp + 16 * ks);
        const GAS f32x4* wp = (const GAS f32x4*)(AT_WI(A) + (rb + t0 + 4 * rt + 2 * H) * 8); const f32x4 x0 = wp[0], x1 = wp[1], y0 = wp[2], y1 = wp[3];
#pragma unroll
        for (int i = 0; i < 4; ++i) { P.wA[rt][i] = x0[i]; P.wA[rt][4 + i] = x1[i]; P.wB[rt][i] = y0[i]; P.wB[rt][4 + i] = y1[i]; }
    }
    const GAS bf16* kp = (const GAS bf16*)(AT_KI(A) + ((size_t)H * M + rb + c) * 8);
#define IDX_LOAD0(dst, tl) do { const int tl_ = (tl) <= tmaxI ? (tl) : tmaxI;     \
        _Pragma("unroll") for (int ks = 0; ks < 4; ++ks) dst[ks] = *(const GAS bf16x8*)(kp + ((size_t)(2 * ks) * M + 32 * tl_) * 8); } while (0)
#pragma unroll
    for (int j = 0; j < RD; ++j) IDX_LOAD0(P.bt[j], wg + j * GW);
#undef IDX_LOAD0
}
__device__ __forceinline__ void grp_barrier(LAS unsigned* ctr, unsigned& gen, const int lane) {
    asm volatile("s_waitcnt lgkmcnt(0)" ::: "memory");
    gen += (unsigned)GW;
    if (lane == 0) __hip_atomic_fetch_add(ctr, 1u, __ATOMIC_RELAXED, __HIP_MEMORY_SCOPE_WORKGROUP);
    while ((unsigned)__builtin_amdgcn_readfirstlane((int)*(volatile LAS unsigned*)ctr) < gen) __builtin_amdgcn_s_sleep(1);
    asm volatile("" ::: "memory");
}
__device__ __forceinline__ void attn_item16(const AttnT& A, const int b, const int t0, const int b_next, const int t0_next, SweepOps& P, LAS unsigned char* lds, const int wave, const int lane_in, LAS unsigned* gctr, unsigned& ggen) {
    const int grp = wave / GW, wg = wave % GW;
    const size_t rb = (size_t)b * SEQ;
    LAS unsigned* sc = (LAS unsigned*)lds;
    LAS unsigned short* lists = (LAS unsigned short*)(lds + L_LIST);
    const LAS unsigned char* bkt = lds + L_BKT; const LAS float* biasb = (const LAS float*)(lds + L_BIASB);
    const int tmaxI = (t0 + GQ - 1) >> 5;
    for (int repi = 0; repi < REP_IDX; ++repi) {
    {
        int lane = lane_in; asm volatile("" : "+v"(lane));
        const int H = lane >> 5, c = lane & 31;
        const GAS bf16* kp = (const GAS bf16*)(AT_KI(A) + ((size_t)H * M + rb + c) * 8);
        LAS unsigned* scA = sc + (GQ * grp + 2 * H) * 2048 + c;
#define IDX_LOAD(dst, tl) do { const int tl_ = (tl) <= tmaxI ? (tl) : tmaxI; _Pragma("unroll") for (int ks = 0; ks < 4; ++ks) dst[ks] = *(const GAS bf16x8*)(kp + ((size_t)(2 * ks) * M + 32 * tl_) * 8); } while (0)
        for (int tile0 = wg; tile0 <= tmaxI; tile0 += RD * GW) {
#pragma unroll
            for (int j = 0; j < RD; ++j) {
                const int tile = tile0 + j * GW;
                if (tile <= tmaxI) {
                    const int kk = 32 * tile + c;
#pragma unroll
                    for (int rt = 0; rt < NRT; ++rt) {
                        f32x16 D;
#pragma unroll
                        for (int r = 0; r < 16; ++r) D[r] = 0.f;
#pragma unroll
                        for (int ks = 0; ks < 4; ++ks) D = __builtin_amdgcn_mfma_f32_32x32x16_bf16(P.aq[rt][ks], P.bt[j][ks], D, 0, 0, 0);
                        float sA = 0.f, sB = 0.f;
#pragma unroll
                        for (int h = 0; h < 8; ++h) { const int da = __float_as_int(D[h]), db = __float_as_int(D[8 + h]);
                            sA = fmaf(P.wA[rt][h], __int_as_float(da > 0 ? da : 0), sA); sB = fmaf(P.wB[rt][h], __int_as_float(db > 0 ? db : 0), sB); }
                        const int tqa = t0 + 4 * rt + 2 * H;
                        if (kk > tqa) sA = -INFINITY;
                        if (kk > tqa + 1) sB = -INFINITY;
                        scA[(4 * rt) * 2048 + 32 * tile] = __float_as_uint(sA); scA[(4 * rt + 1) * 2048 + 32 * tile] = __float_as_uint(sB);
                    }
                }
                IDX_LOAD(P.bt[j], tile + RD * GW);
            }
        }
#undef IDX_LOAD
    }
    grp_barrier(gctr, ggen, lane_in);
    }
    int lane = lane_in; asm volatile("" : "+v"(lane));
    LAS unsigned short* lst0 = lists + (2 * wave) * 256;
    unsigned n0, n1;
    const int tqb = t0 + 2 * wg;
    bf16x8 qv[2][2]; v4u gav[2];
    {
        const int g_ = lane >> 4, hc_ = lane & 15;
#pragma unroll
        for (int qq = 0; qq < 2; ++qq) {
#pragma unroll
            for (int ks = 0; ks < 2; ++ks) { qv[qq][ks] = (bf16x8){0, 0, 0, 0, 0, 0, 0, 0}; if (hc_ < 8) qv[qq][ks] = *(const GAS bf16x8*)(AT_Q(A) + (rb + tqb + qq) * 512 + hc_ * 64 + 32 * ks + 8 * g_); }
            const int hq = lane >> 3;
            gav[qq] = *(const GAS v4u*)(AT_GA(A) + (size_t)(hq >> 2) * TILE_ELEMS + (rb + tqb + qq) * 256 + (hq & 3) * 64 + (lane & 7) * 8);
        }
    }
    AttPF S0, S1, S2;
    AttCtx cx; cx.kb = (const GAS char*)(AT_KN(A) + rb * 64); cx.vb = (const GAS char*)(AT_VV(A) + rb * 64); cx.lst0 = lst0; cx.bkt = bkt; cx.biasb = biasb; cx.g = lane >> 4; cx.hc = lane & 15; cx.lane = lane; cx.tqb = tqb;
    for (int repsel = 0; repsel < REP_SEL; ++repsel)
    {
        const int kmax = 32 * (tmaxI + 1);
        LAS unsigned char* scr = lds + L_SCR + wave * 2048;
#pragma unroll 1
        for (int q = 0; q < 2; ++q) {
            float s[32];
            const LAS unsigned* s0 = sc + (2 * wave + q) * 2048 + lane;
            const int klim = tqb + q + 1;
#pragma unroll
            for (int i = 0; i < 32; ++i) s[i] = __uint_as_float(s0[64 * i]);
            asm volatile("" ::: "memory");
            unsigned nq = 0xffffffffu;
            if (t0 >= 256) nq = select_fused(s, klim, s0, scr, lane, lst0 + q * 256);
            if (nq == 0xffffffffu) {
#pragma unroll
                for (int i = 0; i < 32; ++i) s[i] = (64 * i + lane < klim) ? s[i] : -INFINITY;
                float Ts = -3.0e38f; unsigned tieneed = 4096u;
                if (t0 >= 256) select_bisect(s, Ts, tieneed);
                if (tieneed >= 4096u) nq = select_emit_scan(s, kmax, Ts, lst0 + q * 256, (LAS unsigned short*)(scr + 1536), lane);
                else nq = select_emit(s, kmax, Ts, tieneed, lst0 + q * 256, (LAS unsigned short*)(scr + 1536), lane);
            }
            {
                LAS unsigned short* le = lst0 + q * 256 + 4 * lane;
                asm volatile("" ::: "memory");
                const u32x2 e = *(const LAS u32x2*)le;
                const int tq_ = klim - 1;
                const unsigned k0 = e.x & 0xffffu, k1 = e.x >> 16, k2 = e.y & 0xffffu, k3 = e.y >> 16;
                const unsigned b0 = bkt[tq_ - (int)k0], b1 = bkt[tq_ - (int)k1], b2 = bkt[tq_ - (int)k2], b3 = bkt[tq_ - (int)k3];
                u32x2 o; o.x = e.x | (b0 << 11) | (b1 << 27); o.y = e.y | (b2 << 11) | (b3 << 27);
                *(LAS u32x2*)le = o;
                asm volatile("" ::: "memory");
            }
            if (q == 0) { n0 = nq; cx.ng0 = ((int)nq + 31) >> 5; cx.nu = cx.ng0;
#ifdef EARLY_GATHER
                att_prefetch(S0, cx, 0); att_prefetch(S1, cx, 1); att_prefetch(S2, cx, 2);
#endif
            }
            else n1 = nq;
        }
    }
    __builtin_amdgcn_s_setprio(3);
    for (int repa = 0; repa < REP_ATT; ++repa) {
        const int lane3 = lane;
        const int g = lane3 >> 4, hc = lane3 & 15;
        LAS bf16* Ks = (LAS bf16*)(lds + wave * 16384);
        LAS bf16* Vs = Ks + 32 * KS_LD;
        LAS bf16x8* Qs = (LAS bf16x8*)(Vs + 32 * VS_LD);
        LAS bf16* Gs = (LAS bf16*)(Qs + 256);
        const float SC = 0.125f * LOG2E;
        const int ng0 = cx.ng0, ng1 = ((int)n1 + 31) >> 5, nu = ng0 + ng1;
        cx.nu = nu;
#pragma unroll
        for (int qq = 0; qq < 2; ++qq) {
#pragma unroll
            for (int ks = 0; ks < 2; ++ks) Qs[(qq * 2 + ks) * 64 + lane3] = qv[qq][ks];
            *(LAS v4u*)(Gs + qq * 512 + 8 * lane3) = gav[qq];
        }
#ifdef EARLY_GATHER
        if (0 >= ng0) att_prefetch(S0, cx, 0);
        if (1 >= ng0) att_prefetch(S1, cx, 1);
        if (2 >= ng0) att_prefetch(S2, cx, 2);
#else
        att_prefetch(S0, cx, 0); att_prefetch(S1, cx, 1); att_prefetch(S2, cx, 2);
#endif
        f32x4 O[4];
#pragma unroll
        for (int nt = 0; nt < 4; ++nt) O[nt] = (f32x4){0.f, 0.f, 0.f, 0.f};
        float lsum = 0.f;
        att_stage(S0, cx, Ks, Vs);
#define ATT_STEP(S, N, uu, PF) do { const int u_ = (uu); \
            const int qi = (u_ >= ng0) ? 1 : 0, grp = u_ - (qi ? ng0 : 0); \
            if (u_ == ng0) { qreg[0] = Qs[128 + lane3]; qreg[1] = Qs[128 + 64 + lane3]; } \
            att_step<PF>(S, N, cx, u_, grp, qi ? (int)n1 : (int)n0, qreg, Ks, Vs, SC, O, lsum); \
            if (grp == (qi ? ng1 : ng0) - 1) att_finish(A, rb + tqb + qi, Gs + qi * 512, g, hc, O, lsum); } while (0)
        bf16x8 qreg[2]; qreg[0] = Qs[lane3]; qreg[1] = Qs[64 + lane3];
        int u = 0;
        for (; u + 3 <= nu; u += 3) { ATT_STEP(S0, S1, u, true); ATT_STEP(S1, S2, u + 1, true); ATT_STEP(S2, S0, u + 2, true); }
        if (u < nu) { ATT_STEP(S0, S1, u, false); if (u + 1 < nu) ATT_STEP(S1, S2, u + 1, false); }
#undef ATT_STEP
    }
    __builtin_amdgcn_s_setprio(0);
    sweep_load(P, A, b_next, t0_next, wg, lane_in);
    grp_barrier(gctr, ggen, lane_in);
}

__device__ __forceinline__ void p2_mixers(Frame& F0, int l) {
    Frame F = F0; { int t = F.tid; asm volatile("" : "+v"(t)); F.tid = t; F.lane = t & 63; }
    unsigned char* ws = F.ws;
    LAS unsigned char* bkt = F.lds + L_BKT; LAS float* biasb = (LAS float*)(F.lds + L_BIASB); LAS float* mfx = (LAS float*)(F.lds + L_MFIX);
    if (F.wave == 0) {
        const float gq = fabsf(F.q_norm_g[l * 64 + F.lane]), gk = fabsf(F.k_norm_g[l * 64 + F.lane]);
        float bm = 0.f;
#pragma unroll
        for (int i = 0; i < 4; ++i) bm = fmaxf(bm, fabsf(F.rel_bias[F.lane * 4 + i]));
        const float gqm = wave_max(gq), gkm = wave_max(gk), bmm = wave_max(bm);
        if (F.lane == 0) mfx[0] = 8.0f * gqm * gkm + bmm;
    }
    for (int d = F.tid; d < 2048; d += NWAVES * 64) {
        int bk;
        if (d < 16) bk = d; else { const float v = logf((float)d / 16.0f) / logf(8.0f) * 16.0f; bk = 16 + (int)v; bk = bk > 31 ? 31 : bk; }
        bkt[d] = (unsigned char)bk;
    }
    const float relb = (F.tid < 256) ? F.rel_bias[F.tid] : 0.f;
    for (int reps = 0; reps < REP_SGU; ++reps)
    for (int chn = F.vcu; chn < 256; chn += F.G) {
#ifndef NO_SGU
        sgu_chunk(F, chn * 128, (const bf16*)(ws + WS_VB), (const bf16*)(ws + WS_U), (const bf16*)(ws + WS_GB), (const bf16*)(ws + WS_WSP) + (size_t)l * 4 * 128 * 128,
                  F.b_spatial + l * 512, F.sgu_ln_g + l * 512, F.sgu_ln_b + l * 512, (bf16*)(ws + WS_YB));
#endif
    }
    const AttnT A{ws};
    __syncthreads();
    if (F.tid < 256) biasb[F.tid] = (relb - mfx[0]) * LOG2E;
    LAS unsigned* gctr = (LAS unsigned*)(F.lds + L_GBAR) + 16 * (F.wave / GW);
    if (F.tid < 64) ((LAS unsigned*)(F.lds + L_GBAR))[F.tid] = 0u;
    __syncthreads();
    unsigned ggen = 0u;
    for (int v = F.vcu; v < 256; v += F.G) {
        const int b = v >> 4, j = v & 15, grp = F.wave / GW, wg = F.wave % GW;
#define ITEM_T0(ii) ({ const int i_ = (grp & 1) ? 7 - (ii) : (ii); const int i2_ = (grp & 2) ? (i_ ^ 2) : i_; 16 * ((i2_ & 1) ? (32 * (i2_ >> 1) + 31 - j) : (32 * (i2_ >> 1) + j)) + GQ * grp; })
        SweepOps P;
        sweep_load(P, A, b, ITEM_T0(0), wg, F.lane);
        for (int i = 0; i < 8; ++i) {
            const int t0 = ITEM_T0(i), t0n = (i < 7) ? ITEM_T0(i + 1) : t0;
            attn_item16(A, b, t0, b, t0n, P, F.lds, F.wave, F.lane, gctr, ggen);
        }
#undef ITEM_T0
    }
    __syncthreads();
}

#ifndef REP_P0
#define REP_P0 1
#endif
#ifndef REP_P1
#define REP_P1 1
#endif
#ifndef REP_P2
#define REP_P2 1
#endif
#ifndef REP_P3
#define REP_P3 1
#endif
struct Args { const float* in[12]; float* out; unsigned char* ws; };
__global__ void __launch_bounds__(NWAVES * 64, 2) fwd_mega(Args args) {
    extern __shared__ __attribute__((aligned(16))) unsigned char lds[];
    Frame F;
    F.lds = (LAS unsigned char*)lds;
    F.tid = threadIdx.x; F.lane = F.tid & 63; F.wave = __builtin_amdgcn_readfirstlane(F.tid >> 6);
    F.G = gridDim.x; { const int bx = blockIdx.x; F.vcu = (F.G % 8 == 0) ? (bx % 8) * (F.G / 8) + bx / 8 : bx; }
    F.x = args.in[0]; F.norm_g = args.in[1]; F.w_in = args.in[2]; F.q_norm_g = args.in[3]; F.k_norm_g = args.in[4]; F.rel_bias = args.in[5];
    F.sgu_ln_g = args.in[6]; F.sgu_ln_b = args.in[7]; F.w_spatial = args.in[8]; F.b_spatial = args.in[9]; F.w_branch = args.in[10]; F.w_out = args.in[11];
    F.out = args.out; F.ws = args.ws;
    unsigned char* ws = args.ws;
    for (int u = F.tid; u < (LDS_BYTES - LDSCTL_OFF) / 4; u += NWAVES * 64) ((LAS unsigned*)(F.lds + LDSCTL_OFF))[u] = 0u;
    __syncthreads();
    volatile LAS unsigned* MISC = (volatile LAS unsigned*)(F.lds + MISC_OFF);
    XcdBarrier bar = xcd_barrier_post((unsigned*)(ws + WS_CTL) + CW_BAR, MISC + 8);
#if defined(BAR2)
#define GRID_BAR() do { xcd_barrier(bar); xcd_barrier(bar); } while (0)
#else
#define GRID_BAR() xcd_barrier(bar)
#endif

#if !defined(PHM) || (PHM & 1)
    for (int rep0 = 0; rep0 < REP_P0; ++rep0) p0_prologue(F);
#endif
    GRID_BAR();
    for (int l = 0; l < 2; ++l) {
#if !defined(PHM) || (PHM & 2)
        for (int rep1 = 0; rep1 < REP_P1; ++rep1)
        {
            pg8::Gemm g{(const pg8::bf16_t*)(ws + (l ? WS_X1B : WS_XN)), (const pg8::bf16_t*)(ws + WS_WIN + l * WIN_LAYER), M, NIN, DM, nullptr, nullptr};
            pg8::StaticOrder S; S.init(M, NIN, F.G, (int)blockIdx.x);
            pg8::EpiIn E{ws, F.q_norm_g + l * 64, F.k_norm_g + l * 64, WS_Q, WS_K, WS_QI, WS_WI, l ? (const float*)((unsigned*)(ws + WS_CTL) + CW_RSS) : nullptr};
            pg8::gemm_phase<pg8::EpiIn, pg8::StaticOrder, true, true>(F.lds + RING_OFF, g, S, E);
        }
#endif
        GRID_BAR();
#if !defined(PHM) || (PHM & 4)
        for (int rep2 = 0; rep2 < REP_P2; ++rep2) { p2_mixers(F, l); if (REP_P2 > 1) __syncthreads(); }
#endif
        GRID_BAR();
#if !defined(PHM) || (PHM & 8)
        for (int rep3 = 0; rep3 < REP_P3; ++rep3)
        {
            pg8::TwoSegOrder S; S.init(M, DM, F.G, (int)blockIdx.x);
            pg8::Gemm g{(const pg8::bf16_t*)(ws + WS_YA), (const pg8::bf16_t*)(ws + WS_WBR + (size_t)(l * 2 + 0) * MiB), M, DM, 512,
                        (const pg8::bf16_t*)(ws + WS_YB), (const pg8::bf16_t*)(ws + WS_WBR + (size_t)(l * 2 + 1) * MiB)};
            pg8::EpiMerge E{(const pg8::bf16_t*)(ws + WS_MA), (const pg8::bf16_t*)(ws + WS_MB), (pg8::bf16_t*)(ws + WS_T)};
            pg8::gemm_phase<pg8::EpiMerge, pg8::TwoSegOrder, true, true>(F.lds + RING_OFF, g, S, E);
        }
#endif
        GRID_BAR();
#if !defined(PHM) || (PHM & 16)
        {
            pg8::Gemm g{(const pg8::bf16_t*)(ws + WS_T), (const pg8::bf16_t*)(ws + WS_WOUT + (size_t)l * 2 * MiB), M, DM, DM, nullptr, nullptr};
            pg8::StaticOrder S; S.init(M, DM, F.G, (int)blockIdx.x);
            pg8::EpiOut E{F.x, (const pg8::bf16_t*)(ws + WS_X1B), F.out, (pg8::bf16_t*)(ws + WS_X1B), l, (float*)((unsigned*)(ws + WS_CTL) + CW_RSS)};
            pg8::gemm_phase<pg8::EpiOut, pg8::StaticOrder, true, true>(F.lds + RING_OFF, g, S, E);
        }
#endif
#if !defined(PHM) || (PHM & 32)
        if (l == 0) GRID_BAR();
#endif
    }
#undef GRID_BAR
}

extern "C" void kernel_launch(void* const* d_in, const int* in_sizes, int n_in, void* d_out, int out_size, void* d_ws, size_t ws_size, hipStream_t stream) {
    static int grid = 0;
    if (grid == 0) {
        if (n_in != 12 || in_sizes[0] != M * DM || out_size != M * DM || ws_size < WS_END) { fprintf(stderr, "kernel_launch: unexpected shapes: n_in %d in0 %d out %d ws %zu (need %zu)\n", n_in, n_in > 0 ? in_sizes[0] : -1, out_size, ws_size, (size_t)WS_END); grid = -1; return; }
        int dev = 0, cus = 0, per_cu = 0;
        if (hipGetDevice(&dev) != hipSuccess || hipDeviceGetAttribute(&cus, hipDeviceAttributeMultiprocessorCount, dev) != hipSuccess) { fprintf(stderr, "kernel_launch: device query failed\n"); grid = -1; return; }
        if (hipFuncSetAttribute((const void*)fwd_mega, hipFuncAttributeMaxDynamicSharedMemorySize, LDS_BYTES) != hipSuccess) { fprintf(stderr, "kernel_launch: hipFuncSetAttribute failed\n"); grid = -1; return; }
        if (hipOccupancyMaxActiveBlocksPerMultiprocessor(&per_cu, (const void*)fwd_mega, NWAVES * 64, LDS_BYTES) != hipSuccess || per_cu < 1) { fprintf(stderr, "kernel_launch: occupancy query reports %d workgroups per CU\n", per_cu); }
        (void)hipGetLastError();
        grid = cus;
        if (grid != 256) fprintf(stderr, "kernel_launch: note: %d CUs\n", grid);
    }
    if (grid < 0) return;
    if (hipMemsetAsync((char*)d_ws + WS_CTL, 0, CTL_ZERO_BYTES, stream) != hipSuccess) { fprintf(stderr, "kernel_launch: memset failed\n"); return; }
    Args a{};
    for (int i = 0; i < 12; ++i) a.in[i] = (const float*)d_in[i];
    a.out = (float*)d_out; a.ws = (unsigned char*)d_ws;
    hipLaunchKernelGGL(fwd_mega, dim3(grid), dim3(NWAVES * 64), LDS_BYTES, stream, a);
    const hipError_t le = hipPeekAtLastError();
    if (le != hipSuccess) fprintf(stderr, "kernel_launch: launch failed: %s\n", hipGetErrorName(le));
}
```

```cpp
#include <hip/hip_runtime.h>
#include <cstdio>
#include <cstdint>
#include <cmath>
namespace pg8 {
#define PG8_LAS __attribute__((address_space(3)))
typedef unsigned short bf16_t;
typedef short bf16x8 __attribute__((ext_vector_type(8)));
typedef float f32x4 __attribute__((ext_vector_type(4)));
typedef unsigned u32x4 __attribute__((ext_vector_type(4)));
constexpr int BM = 256, BK = 64, HALF = 128, HTB = HALF * BK * 2  , STAGE_BYTES = 8 * HTB, NXCD = 8, WGM = 2;

__host__ __device__ __forceinline__ int lds_byte(int r, int c) { const int st = (r >> 4) * 2 + (c >> 5), rr = r & 15, cc = c & 31, ob = rr * 64 + cc * 2; return st * 1024 + (ob ^ (((ob >> 9) & 1) << 5)); }
__host__ __device__ __forceinline__ void stage_rc(int b, int& R, int& C) { const int st = b / 1024, sb = b % 1024, swz = sb ^ (((sb >> 9) & 1) << 5); R = (st >> 1) * 16 + swz / 64; C = (st & 1) * 32 + (swz % 64) / 2; }
__host__ __device__ __forceinline__ int perm32(int rho) { const int n = rho >> 4, i = rho & 15; return 8 * (i >> 2) + 4 * n + (i & 3); }

struct Unit { int pm, pn, seg; };
struct Gemm { const bf16_t* A; const bf16_t* Bt; int M, N, K; const bf16_t* A2; const bf16_t* Bt2; };

struct StaticOrder {
    int nM, nN, nwg, G, c, wgm;
    __host__ __device__ void init(int M, int N, int G_, int c_, int wgm_ = WGM) { nM = M / BM; nN = N / BM; nwg = nM * nN; G = G_; c = c_; wgm = wgm_; }
    __host__ __device__ bool next(int i, Unit& u) const {
        const long L = (long)i * G + c; if (L >= nwg) return false;
        int wgid = (int)L; { const int q = nwg / NXCD, r = nwg % NXCD, xcd = wgid % NXCD, off = wgid / NXCD; wgid = (xcd < r ? xcd * (q + 1) : r * (q + 1) + (xcd - r) * q) + off; }
        const int nig = wgm * nN, gid = wgid / nig, fm = gid * wgm, gsz = (nM - fm) < wgm ? (nM - fm) : wgm;
        u.pm = fm + ((wgid % nig) % gsz); u.pn = (wgid % nig) / gsz; u.seg = 0; return true;
    }
    __device__ __forceinline__ void a_ready(const Unit&) const {}
    __device__ __forceinline__ void done(const Unit&) const {}
};
struct TwoSegOrder {
    StaticOrder base;
    __host__ __device__ void init(int M, int N, int G_, int c_, int wgm_ = WGM) { base.init(M, N, G_, c_, wgm_); }
    __host__ __device__ bool next(int i, Unit& u) const { if (!base.next(i >> 1, u)) return false; u.seg = i & 1; return true; }
    __device__ __forceinline__ void a_ready(const Unit&) const {}
    __device__ __forceinline__ void done(const Unit&) const {}
};

typedef float f32x2_cv __attribute__((ext_vector_type(2))); typedef __bf16 bf16x2_cv __attribute__((ext_vector_type(2)));
__device__ __forceinline__ unsigned cvt_pk_bf16(float lo, float hi) { f32x2_cv v = {lo, hi}; bf16x2_cv b = __builtin_convertvector(v, bf16x2_cv); return __builtin_bit_cast(unsigned, b); }

typedef unsigned u32x2_e __attribute__((ext_vector_type(2)));
__device__ __forceinline__ float bf_lo(unsigned w) { return __uint_as_float(w << 16); }
__device__ __forceinline__ float bf_hi(unsigned w) { return __uint_as_float(w & 0xffff0000u); }
__device__ __forceinline__ float fast_sigmoid(float x) { return __builtin_amdgcn_rcpf(1.0f + __builtin_amdgcn_exp2f(-1.4426950408889634f * x)); }
typedef float f32x2_a __attribute__((ext_vector_type(2)));
__device__ __forceinline__ f32x2_a sig2_from_arg(f32x2_a a) {
    f32x2_a e2; e2.x = __builtin_amdgcn_exp2f(a.x); e2.y = __builtin_amdgcn_exp2f(a.y);
    const f32x2_a d = e2 + (f32x2_a){1.0f, 1.0f};
    f32x2_a r; r.x = __builtin_amdgcn_rcpf(d.x); r.y = __builtin_amdgcn_rcpf(d.y); return r;
}
__device__ __forceinline__ f32x2_a sigden2(f32x2_a x) {
    f32x2_a a = x * (f32x2_a){-1.4426950408889634f, -1.4426950408889634f}; a.x = fminf(a.x, 100.0f); a.y = fminf(a.y, 100.0f);
    f32x2_a e2; e2.x = __builtin_amdgcn_exp2f(a.x); e2.y = __builtin_amdgcn_exp2f(a.y); return e2 + (f32x2_a){1.0f, 1.0f};
}
__device__ __forceinline__ f32x2_a sigmoid2(f32x2_a x) { return sig2_from_arg(x * (f32x2_a){-1.4426950408889634f, -1.4426950408889634f}); }
__device__ __forceinline__ f32x2_a silu2(f32x2_a x) { return x * sigmoid2(x); }
__device__ __forceinline__ f32x2_a gelu2(f32x2_a x) {
    const f32x2_a t = (x * x) * (f32x2_a){-0.07135481627f * 1.4426950408889634f, -0.07135481627f * 1.4426950408889634f} + (f32x2_a){-1.5957691216f * 1.4426950408889634f, -1.5957691216f * 1.4426950408889634f};
    return x * sig2_from_arg(x * t);
}
__device__ __forceinline__ u32x4 pack8(const f32x4& a, const f32x4& b) { u32x4 w; w.x = cvt_pk_bf16(a[0], a[1]); w.y = cvt_pk_bf16(a[2], a[3]); w.z = cvt_pk_bf16(b[0], b[1]); w.w = cvt_pk_bf16(b[2], b[3]); return w; }

struct EpiIn {
    static constexpr bool PERM = true, AFTER_DRAIN = false, TWOSEG = false;
    unsigned char* ws; const float *qg, *kg;
    size_t oQ, oKVI, oTB, oWI;
    __device__ __forceinline__ void operator()(const f32x4 (&acc)[2][2][4][2], const Unit& u, int wr, int wc, int fr, int fq) const {
        asm volatile("" : "+v"(fr), "+v"(fq));
        int pn = u.pn; asm volatile("" : "+s"(pn));
        const int row0 = u.pm * BM + wr * 64 + fr;
        if (pn < 2) {
            bf16_t* dst = (bf16_t*)(ws + oQ) + (4 * pn + wc) * 64 + 8 * fq;
#pragma unroll
            for (int ai = 0; ai < 2; ++ai)
#pragma unroll
                for (int m = 0; m < 4; ++m) {
                    const int row = row0 + ai * HALF + m * 16;
                    float ss = 0.f;
#pragma unroll
                    for (int bj = 0; bj < 2; ++bj)
#pragma unroll
                        for (int n = 0; n < 2; ++n) { const f32x4 x = acc[ai][bj][m][n]; ss += (x[0] * x[0] + x[1] * x[1]) + (x[2] * x[2] + x[3] * x[3]); }
                    ss += __shfl_xor(ss, 16); ss += __shfl_xor(ss, 32);
                    const float rs = 1.0f / sqrtf(ss * (1.0f / 64.0f) + 1e-6f);
#pragma unroll
                    for (int bj = 0; bj < 2; ++bj) {
                        const f32x4 v0 = acc[ai][bj][m][0] * rs * *(const f32x4*)(qg + 32 * bj + 8 * fq), v1 = acc[ai][bj][m][1] * rs * *(const f32x4*)(qg + 32 * bj + 8 * fq + 4);
                        *(u32x4*)(dst + (size_t)row * 512 + 32 * bj) = pack8(v0, v1);
                    }
                    asm volatile("" ::: "memory");
                }
        } else if (pn == 2) {
            bf16_t* dst = (bf16_t*)(ws + oKVI + (size_t)wc * (4u << 20)) + 8 * fq;
            float* WI = (float*)(ws + oWI);
#pragma unroll
            for (int ai = 0; ai < 2; ++ai)
#pragma unroll
                for (int m = 0; m < 4; ++m) {
                    const int row = row0 + ai * HALF + m * 16;
                    float ss = 0.f;
#pragma unroll
                    for (int bj = 0; bj < 2; ++bj)
#pragma unroll
                        for (int n = 0; n < 2; ++n) { const f32x4 x = acc[ai][bj][m][n]; ss += (x[0] * x[0] + x[1] * x[1]) + (x[2] * x[2] + x[3] * x[3]); }
                    ss += __shfl_xor(ss, 16); ss += __shfl_xor(ss, 32);
                    const float rs = (wc == 0) ? 1.0f / sqrtf(ss * (1.0f / 64.0f) + 1e-6f) : 1.0f;
                    if (wc == 3) { if (fq == 0) { *(f32x4*)(WI + (size_t)row * 8) = acc[ai][0][m][0]; *(f32x4*)(WI + (size_t)row * 8 + 4) = acc[ai][0][m][1]; } }
                    else if (wc == 2) {
#pragma unroll
                        for (int bj = 0; bj < 2; ++bj) *(u32x4*)((bf16_t*)(ws + oKVI + (size_t)2 * (4u << 20)) + ((size_t)(4 * bj + fq) * 32768 + row) * 8) = pack8(acc[ai][bj][m][0], acc[ai][bj][m][1]);
                    } else {
#pragma unroll
                        for (int bj = 0; bj < 2; ++bj) {
                            f32x4 g0 = *(const f32x4*)(kg + 32 * bj + 8 * fq), g1 = *(const f32x4*)(kg + 32 * bj + 8 * fq + 4);
                            if (wc != 0) { g0 = (f32x4){1.f, 1.f, 1.f, 1.f}; g1 = g0; }
                            const f32x4 v0 = acc[ai][bj][m][0] * rs * g0, v1 = acc[ai][bj][m][1] * rs * g1;
                            *(u32x4*)(dst + (size_t)row * 64 + 32 * bj) = pack8(v0, v1);
                        }
                    }
                    asm volatile("" ::: "memory");
                }
        } else {
            bf16_t* dst = (bf16_t*)(ws + oTB + (size_t)(pn - 3) * (16u << 20)) + 32 * wc + 8 * fq;
            const int mode = (pn < 5) ? 0 : ((pn >= 13) ? 3 : ((pn >= 7 && pn < 11) ? 2 : 1));
#define EPI_N_LOOP(BODY) _Pragma("unroll") for (int ai = 0; ai < 2; ++ai) _Pragma("unroll") for (int m = 0; m < 4; ++m) { const int row = row0 + ai * HALF + m * 16; \
                _Pragma("unroll") for (int bj = 0; bj < 2; ++bj) { f32x4 v0 = acc[ai][bj][m][0], v1 = acc[ai][bj][m][1]; \
                    _Pragma("unroll") for (int i = 0; i < 2; ++i) { f32x2_a x = (f32x2_a){v0[2 * i], v0[2 * i + 1]}; BODY; v0[2 * i] = x.x; v0[2 * i + 1] = x.y; x = (f32x2_a){v1[2 * i], v1[2 * i + 1]}; BODY; v1[2 * i] = x.x; v1[2 * i + 1] = x.y; } \
                    __builtin_nontemporal_store(pack8(v0, v1), (u32x4*)(dst + (size_t)row * 256 + 128 * bj)); } \
                asm volatile("" ::: "memory"); }
            if (pn >= 13) {
                const int t = pn - 13;
                bf16_t* dR = (bf16_t*)(ws + oTB + (size_t)(10 + (t >> 1)) * (16u << 20)) + (t & 1) * 128 + 32 * wc + 8 * fq;
                bf16_t* dS = (bf16_t*)(ws + oTB + (size_t)(14 + (t >> 1)) * (16u << 20)) + (t & 1) * 128 + 32 * wc + 8 * fq;
#pragma unroll
                for (int ai = 0; ai < 2; ++ai)
#pragma unroll
                    for (int m = 0; m < 4; ++m) { const int row = row0 + ai * HALF + m * 16;
                        f32x4 rr[2], ss[2];
#pragma unroll
                        for (int n = 0; n < 2; ++n)
#pragma unroll
                            for (int i = 0; i < 2; ++i) {
                                const f32x2_a xa = (f32x2_a){acc[ai][0][m][n][2 * i], acc[ai][0][m][n][2 * i + 1]}, xb = (f32x2_a){acc[ai][1][m][n][2 * i], acc[ai][1][m][n][2 * i + 1]};
                                const f32x2_a ea = sigden2(xa), eb = sigden2(xb);
                                f32x2_a ia, ib; ia.x = __builtin_amdgcn_rcpf(ea.x); ia.y = __builtin_amdgcn_rcpf(ea.y); ib.x = __builtin_amdgcn_rcpf(eb.x); ib.y = __builtin_amdgcn_rcpf(eb.y);
                                const f32x2_a r = eb * ia;
                                rr[n][2 * i] = r.x; rr[n][2 * i + 1] = r.y; ss[n][2 * i] = ib.x; ss[n][2 * i + 1] = ib.y;
                            }
                        __builtin_nontemporal_store(pack8(rr[0], rr[1]), (u32x4*)(dR + (size_t)row * 256)); __builtin_nontemporal_store(pack8(ss[0], ss[1]), (u32x4*)(dS + (size_t)row * 256));
                        asm volatile("" ::: "memory"); }
            }
            else if (pn == 7 || pn == 8 || pn == 11 || pn == 12) {
                const int t = (pn == 7) ? 0 : (pn == 8) ? 1 : (pn == 11) ? 2 : 3;
                bf16_t* dP = (bf16_t*)(ws + oTB + (size_t)(4 + (t >> 1)) * (16u << 20)) + (t & 1) * 128 + 32 * wc + 8 * fq;
#pragma unroll
                for (int ai = 0; ai < 2; ++ai)
#pragma unroll
                    for (int m = 0; m < 4; ++m) { const int row = row0 + ai * HALF + m * 16;
                        f32x4 pp[2];
#pragma unroll
                        for (int n = 0; n < 2; ++n)
#pragma unroll
                            for (int i = 0; i < 2; ++i) {
                                const f32x2_a xu = (f32x2_a){acc[ai][0][m][n][2 * i], acc[ai][0][m][n][2 * i + 1]}, xg = (f32x2_a){acc[ai][1][m][n][2 * i], acc[ai][1][m][n][2 * i + 1]};
                                const f32x2_a pr = gelu2(xu) * silu2(xg);
                                pp[n][2 * i] = pr.x; pp[n][2 * i + 1] = pr.y;
                            }
                        __builtin_nontemporal_store(pack8(pp[0], pp[1]), (u32x4*)(dP + (size_t)row * 256));
                        asm volatile("" ::: "memory"); }
            }
            else if (mode == 0) { EPI_N_LOOP((void)0) }
            else if (mode == 1) { EPI_N_LOOP(x = silu2(x)) }
            else if (mode == 2) { EPI_N_LOOP(x = gelu2(x)) }
            else                { EPI_N_LOOP(x = sigmoid2(x)) }
#undef EPI_N_LOOP
        }
    }
};

struct EpiBrA {
    static constexpr bool PERM = true, AFTER_DRAIN = false, TWOSEG = false;
    const bf16_t* G; bf16_t* T;
    __device__ __forceinline__ void operator()(const f32x4 (&acc)[2][2][4][2], const Unit& u, int wr, int wc, int fr, int fq) const {
        asm volatile("" : "+v"(fr), "+v"(fq));
        const int row0 = u.pm * BM + wr * 64 + fr, colw = u.pn * BM + 32 * wc + 8 * fq;
#pragma unroll
        for (int ai = 0; ai < 2; ++ai)
#pragma unroll
            for (int m = 0; m < 4; ++m) {
                const size_t ro = (size_t)(row0 + ai * HALF + m * 16) * 1024 + colw;
#pragma unroll
                for (int bj = 0; bj < 2; ++bj) {
                    const u32x4 gw = *(const u32x4*)(G + (size_t)u.pn * ((size_t)8 << 20) + (size_t)(row0 + ai * HALF + m * 16) * 256 + (32 * wc + 8 * fq) + 128 * bj);
                    f32x4 v0 = acc[ai][bj][m][0], v1 = acc[ai][bj][m][1];
                    v0[0] *= bf_lo(gw.x); v0[1] *= bf_hi(gw.x); v0[2] *= bf_lo(gw.y); v0[3] *= bf_hi(gw.y);
                    v1[0] *= bf_lo(gw.z); v1[1] *= bf_hi(gw.z); v1[2] *= bf_lo(gw.w); v1[3] *= bf_hi(gw.w);
                    *(u32x4*)(T + ro + 128 * bj) = pack8(v0, v1);
                }
                asm volatile("" ::: "memory");
            }
    }
};
struct EpiBrB {
    static constexpr bool PERM = true, AFTER_DRAIN = false, TWOSEG = false;
    const bf16_t* G; bf16_t* T;
    __device__ __forceinline__ void operator()(const f32x4 (&acc)[2][2][4][2], const Unit& u, int wr, int wc, int fr, int fq) const {
        asm volatile("" : "+v"(fr), "+v"(fq));
        const int row0 = u.pm * BM + wr * 64 + fr, colw = u.pn * BM + 32 * wc + 8 * fq;
#pragma unroll
        for (int ai = 0; ai < 2; ++ai)
#pragma unroll
            for (int m = 0; m < 4; ++m) {
                const size_t ro = (size_t)(row0 + ai * HALF + m * 16) * 1024 + colw;
#pragma unroll
                for (int bj = 0; bj < 2; ++bj) {
                    const u32x4 gw = *(const u32x4*)(G + (size_t)u.pn * ((size_t)8 << 20) + (size_t)(row0 + ai * HALF + m * 16) * 256 + (32 * wc + 8 * fq) + 128 * bj);
                    const u32x4 tw = *(const u32x4*)(T + ro + 128 * bj);
                    f32x4 v0 = acc[ai][bj][m][0], v1 = acc[ai][bj][m][1];
                    v0[0] = v0[0] * bf_lo(gw.x) + bf_lo(tw.x); v0[1] = v0[1] * bf_hi(gw.x) + bf_hi(tw.x); v0[2] = v0[2] * bf_lo(gw.y) + bf_lo(tw.y); v0[3] = v0[3] * bf_hi(gw.y) + bf_hi(tw.y);
                    v1[0] = v1[0] * bf_lo(gw.z) + bf_lo(tw.z); v1[1] = v1[1] * bf_hi(gw.z) + bf_hi(tw.z); v1[2] = v1[2] * bf_lo(gw.w) + bf_lo(tw.w); v1[3] = v1[3] * bf_hi(gw.w) + bf_hi(tw.w);
                    *(u32x4*)(T + ro + 128 * bj) = pack8(v0, v1);
                }
                asm volatile("" ::: "memory");
            }
    }
};
struct EpiOut {
    static constexpr bool PERM = false, AFTER_DRAIN = false, TWOSEG = false;
    const float* base32; const bf16_t* base16; float* out32; bf16_t* out16; int last;
    __device__ __forceinline__ void operator()(const f32x4 (&acc)[2][2][4][2], const Unit& u, int wr, int wc, int fr, int fq) const {
        asm volatile("" : "+v"(fr), "+v"(fq));
        const int row0 = u.pm * BM + wr * 64 + fr, col0 = u.pn * BM + wc * 32 + 4 * fq;
        const int wofs = (fq & 1) ? 12 : 0;
        if (!last) {
#pragma unroll
            for (int ai = 0; ai < 2; ++ai)
#pragma unroll
                for (int m = 0; m < 4; ++m) {
                    const size_t ro = (size_t)(row0 + ai * HALF + m * 16) * 1024 + col0;
#pragma unroll
                    for (int bj = 0; bj < 2; ++bj) {
                        const f32x4 v0 = __builtin_nontemporal_load((const f32x4*)(base32 + ro + bj * HALF)) + acc[ai][bj][m][0], v1 = __builtin_nontemporal_load((const f32x4*)(base32 + ro + bj * HALF + 16)) + acc[ai][bj][m][1];
                        const unsigned a0 = cvt_pk_bf16(v0[0], v0[1]), a1 = cvt_pk_bf16(v0[2], v0[3]), b0 = cvt_pk_bf16(v1[0], v1[1]), b1 = cvt_pk_bf16(v1[2], v1[3]);
                        const auto s0 = __builtin_amdgcn_permlane16_swap(a0, b0, false, false), s1 = __builtin_amdgcn_permlane16_swap(a1, b1, false, false);
                        u32x4 o; o.x = s0[0]; o.y = s1[0]; o.z = s0[1]; o.w = s1[1];
                        *(u32x4*)(out16 + ro + bj * HALF + wofs) = o;
                    }
                }
        } else {
#pragma unroll
            for (int ai = 0; ai < 2; ++ai)
#pragma unroll
                for (int m = 0; m < 4; ++m) {
                    const size_t ro = (size_t)(row0 + ai * HALF + m * 16) * 1024 + col0;
#pragma unroll
                    for (int bj = 0; bj < 2; ++bj) {
                        const u32x4 w = *(const u32x4*)(base16 + ro + bj * HALF + wofs);
                        const auto s0 = __builtin_amdgcn_permlane16_swap(w.x, w.z, false, false), s1 = __builtin_amdgcn_permlane16_swap(w.y, w.w, false, false);
                        const f32x4 b0 = (f32x4){bf_lo(s0[0]), bf_hi(s0[0]), bf_lo(s1[0]), bf_hi(s1[0])}, b1 = (f32x4){bf_lo(s0[1]), bf_hi(s0[1]), bf_lo(s1[1]), bf_hi(s1[1])};
                        *(f32x4*)(out32 + ro + bj * HALF) = b0 + acc[ai][bj][m][0]; *(f32x4*)(out32 + ro + bj * HALF + 16) = b1 + acc[ai][bj][m][1];
                    }
                }
        }
    }
};

struct EpiMerge {
    static constexpr bool PERM = true, AFTER_DRAIN = false, TWOSEG = true;
    const bf16_t* GA; const bf16_t* GB; bf16_t* T;
    __device__ __forceinline__ void mid(f32x4 (&acc)[2][2][4][2], const Unit& u, int wr, int wc, int fr, int fq) const {
        asm volatile("" : "+v"(fr), "+v"(fq));
        const int row0 = u.pm * BM + wr * 64 + fr;
        const size_t tb = (size_t)u.pn * ((size_t)8 << 20) + (32 * wc + 8 * fq);
        u32x4 aw[2][2];
#define MG_LOAD(slot, k) do { const size_t go_ = tb + (size_t)(row0 + ((k) >> 2) * HALF + ((k) & 3) * 16) * 256; \
            aw[slot][0] = *(const u32x4*)(GA + go_); aw[slot][1] = *(const u32x4*)(GA + go_ + 128); } while (0)
        MG_LOAD(0, 0);
#pragma unroll
        for (int k = 0; k < 8; ++k) {
            const int ai = k >> 2, m = k & 3, s = k & 1;
            if (k < 7) MG_LOAD(s ^ 1, k + 1);
#pragma unroll
            for (int bj = 0; bj < 2; ++bj) {
                const unsigned aws[4] = {aw[s][bj].x, aw[s][bj].y, aw[s][bj].z, aw[s][bj].w};
#pragma unroll
                for (int i = 0; i < 4; ++i) {
                    const float r0 = bf_lo(aws[i]), r1 = bf_hi(aws[i]);
                    if (i < 2) { acc[ai][bj][m][0][2 * i] *= r0; acc[ai][bj][m][0][2 * i + 1] *= r1; } else { acc[ai][bj][m][1][2 * i - 4] *= r0; acc[ai][bj][m][1][2 * i - 3] *= r1; }
                }
            }
        }
#undef MG_LOAD
    }
    __device__ __forceinline__ void operator()(const f32x4 (&acc)[2][2][4][2], const Unit& u, int wr, int wc, int fr, int fq) const {
        asm volatile("" : "+v"(fr), "+v"(fq));
        const int row0 = u.pm * BM + wr * 64 + fr, colw = u.pn * BM + 32 * wc + 8 * fq;
        const size_t tb = (size_t)u.pn * ((size_t)8 << 20) + (32 * wc + 8 * fq);
        u32x4 gw[2][2];
#define MG_LOAD(slot, k) do { const size_t go_ = tb + (size_t)(row0 + ((k) >> 2) * HALF + ((k) & 3) * 16) * 256; gw[slot][0] = *(const u32x4*)(GB + go_); gw[slot][1] = *(const u32x4*)(GB + go_ + 128); } while (0)
        MG_LOAD(0, 0);
#pragma unroll
        for (int k = 0; k < 8; ++k) {
            const int ai = k >> 2, m = k & 3, s = k & 1;
            if (k < 7) MG_LOAD(s ^ 1, k + 1);
            const size_t ro = (size_t)(row0 + ai * HALF + m * 16) * 1024 + colw;
#pragma unroll
            for (int bj = 0; bj < 2; ++bj) {
                const u32x4 g = gw[s][bj];
                f32x4 v0 = acc[ai][bj][m][0], v1 = acc[ai][bj][m][1];
                v0[0] *= bf_lo(g.x); v0[1] *= bf_hi(g.x); v0[2] *= bf_lo(g.y); v0[3] *= bf_hi(g.y);
                v1[0] *= bf_lo(g.z); v1[1] *= bf_hi(g.z); v1[2] *= bf_lo(g.w); v1[3] *= bf_hi(g.w);
                *(u32x4*)(T + ro + 128 * bj) = pack8(v0, v1);
            }
        }
#undef MG_LOAD
    }
};
template <class Epi, class Sched, bool ALIGN_EPI = false, bool SP2 = false>
__device__ __forceinline__ void gemm_phase(PG8_LAS unsigned char* lds, const Gemm g, const Sched& S, const Epi& E) {
    int tid = threadIdx.x; asm volatile("" : "+v"(tid));
    const int wid = __builtin_amdgcn_readfirstlane(tid >> 6), lane = tid & 63, wr = wid >> 2, wc = wid & 3, fr = lane & 15, fq = lane >> 4;
    const int K = g.K, nt = K / BK;
    unsigned voffA[2], voffB[2];
#pragma unroll
    for (int i = 0; i < 2; ++i) { int R, C; stage_rc(tid * 16 + i * 8192, R, C); const int Rb = Epi::PERM ? ((R & ~31) + perm32(R & 31)) : R;
        voffA[i] = (unsigned)(R * K + C) * 2u; voffB[i] = (unsigned)(Rb * K + C) * 2u; }
    const size_t kstep = (size_t)(BK * 2);
    const size_t hstep = (size_t)HALF * K * 2;
    const size_t tstep = 2 * hstep;
    const unsigned ldsw = (unsigned)wid * 1024u;
    const int aoff = lds_byte(wr * 64 + fr, fq * 8), boff = lds_byte(wc * 32 + fr, fq * 8);
#define PG8_SA(b, h) (((b) * 2 + (h)) * HTB)
#define PG8_SB(b, h) ((4 + (b) * 2 + (h)) * HTB)
#define PG8_STAGE(bufoff, gbase, voff) do { _Pragma("unroll") for (int _i = 0; _i < 2; ++_i) \
        __builtin_amdgcn_global_load_lds((const unsigned*)((const char*)(gbase) + (voff)[_i]), (PG8_LAS unsigned*)(lds + (bufoff) + ldsw + _i * 8192), 16, 0, 0); } while (0)
#define PG8_LDA(dst, b, h) do { _Pragma("unroll") for (int m = 0; m < 4; ++m) _Pragma("unroll") for (int k = 0; k < 2; ++k) dst[m][k] = *(const PG8_LAS bf16x8*)(lds + PG8_SA(b, h) + aoff + m * 2048 + k * 1024); } while (0)
#define PG8_LDB(dst, b, h) do { _Pragma("unroll") for (int n = 0; n < 2; ++n) _Pragma("unroll") for (int k = 0; k < 2; ++k) dst[n][k] = *(const PG8_LAS bf16x8*)(lds + PG8_SB(b, h) + boff + n * 2048 + k * 1024); } while (0)
#define PG8_MMA(ai, bj, At, Bt) do { __builtin_amdgcn_s_setprio(1); _Pragma("unroll") for (int m = 0; m < 4; ++m) _Pragma("unroll") for (int n = 0; n < 2; ++n) _Pragma("unroll") for (int k = 0; k < 2; ++k) \
        acc[ai][bj][m][n] = __builtin_amdgcn_mfma_f32_16x16x32_bf16(Bt[n][k], At[m][k], acc[ai][bj][m][n], 0, 0, 0); __builtin_amdgcn_s_setprio(0); } while (0)
#define PG8_WAIT_V(n) asm volatile("s_waitcnt vmcnt(" #n ")" ::: "memory")
#define PG8_WAIT_L(n) asm volatile("s_waitcnt lgkmcnt(" #n ")" ::: "memory")
#define PG8_BAR __builtin_amdgcn_s_barrier()
#define PG8_SCHED __builtin_amdgcn_sched_barrier(0)
    Unit cur, nxt; int ui = 0;
    if (!S.next(0, cur)) return;
    f32x4 acc[2][2][4][2];
#pragma unroll
    for (int a = 0; a < 2; ++a)
#pragma unroll
        for (int b = 0; b < 2; ++b)
#pragma unroll
            for (int m = 0; m < 4; ++m)
#pragma unroll
                for (int n = 0; n < 2; ++n) acc[a][b][m][n] = (f32x4){0.f, 0.f, 0.f, 0.f};
    bf16x8 At[4][2], B0[2][2], B1[2][2];
    const char* cA = (const char*)((Epi::TWOSEG && cur.seg) ? g.A2 : g.A) + (size_t)cur.pm * tstep; const char* cB = (const char*)((Epi::TWOSEG && cur.seg) ? g.Bt2 : g.Bt) + (size_t)cur.pn * tstep;
    S.a_ready(cur);
    if constexpr (SP2) {
        PG8_STAGE(PG8_SB(0, 0), cB, voffB); PG8_STAGE(PG8_SB(0, 1), cB + hstep, voffB); PG8_STAGE(PG8_SA(0, 0), cA, voffA); PG8_STAGE(PG8_SA(0, 1), cA + hstep, voffA);
        if (wr == 1) PG8_BAR;
        PG8_WAIT_V(2); PG8_BAR;
        PG8_STAGE(PG8_SB(1, 0), cB + kstep, voffB); PG8_STAGE(PG8_SA(1, 0), cA + kstep, voffA); PG8_STAGE(PG8_SB(1, 1), cB + hstep + kstep, voffB);
        PG8_WAIT_V(6); PG8_BAR;
    } else {
        PG8_STAGE(PG8_SB(0, 0), cB, voffB); PG8_STAGE(PG8_SA(0, 0), cA, voffA); PG8_STAGE(PG8_SB(0, 1), cB + hstep, voffB); PG8_STAGE(PG8_SA(0, 1), cA + hstep, voffA);
        if (wr == 1) PG8_BAR;
        PG8_WAIT_V(4); PG8_BAR;
        PG8_STAGE(PG8_SB(1, 0), cB + kstep, voffB); PG8_STAGE(PG8_SA(1, 0), cA + kstep, voffA); PG8_STAGE(PG8_SB(1, 1), cB + hstep + kstep, voffB);
        PG8_WAIT_V(6); PG8_BAR;
    }
    for (;;) {
        const bool has_next = S.next(ui + 1, nxt);
        const char* nA = has_next ? (const char*)((Epi::TWOSEG && nxt.seg) ? g.A2 : g.A) + (size_t)nxt.pm * tstep : cA; const char* nB = has_next ? (const char*)((Epi::TWOSEG && nxt.seg) ? g.Bt2 : g.Bt) + (size_t)nxt.pn * tstep : cB;
        for (int t = 0; t < nt; t += 2) {
            const bool last = (t == nt - 2);
            const char* a1 = cA + (size_t)(t + 1) * kstep;
            const char* a2 = last ? nA : cA + (size_t)(t + 2) * kstep; const char* b2 = last ? nB : cB + (size_t)(t + 2) * kstep;
            const char* a3 = a2 + kstep; const char* b3 = b2 + kstep;
            if (last && has_next) S.a_ready(nxt);
            if constexpr (SP2) {
            PG8_LDB(B0, 0, 0); PG8_LDB(B1, 0, 1); PG8_SCHED; PG8_LDA(At, 0, 0); PG8_STAGE(PG8_SA(1, 1), a1 + hstep, voffA);
            PG8_WAIT_V(8); PG8_WAIT_L(0); PG8_BAR; PG8_MMA(0, 0, At, B0); PG8_MMA(0, 1, At, B1); PG8_BAR; PG8_SCHED;
            PG8_LDA(At, 0, 1); PG8_STAGE(PG8_SB(0, 0), b2, voffB); PG8_STAGE(PG8_SB(0, 1), b2 + hstep, voffB); PG8_STAGE(PG8_SA(0, 0), a2, voffA);
            PG8_WAIT_V(8); PG8_WAIT_L(0); PG8_BAR; PG8_MMA(1, 0, At, B0); PG8_MMA(1, 1, At, B1); PG8_BAR; PG8_SCHED;
            PG8_LDB(B0, 1, 0); PG8_LDB(B1, 1, 1); PG8_SCHED; PG8_LDA(At, 1, 0); PG8_STAGE(PG8_SA(0, 1), a2 + hstep, voffA);
            PG8_WAIT_V(8); PG8_WAIT_L(0); PG8_BAR; PG8_MMA(0, 0, At, B0); PG8_MMA(0, 1, At, B1); PG8_BAR; PG8_SCHED;
            PG8_LDA(At, 1, 1); PG8_STAGE(PG8_SB(1, 0), b3, voffB); PG8_STAGE(PG8_SB(1, 1), b3 + hstep, voffB); PG8_STAGE(PG8_SA(1, 0), a3, voffA);
            PG8_WAIT_V(8); PG8_WAIT_L(0); PG8_BAR; PG8_MMA(1, 0, At, B0); PG8_MMA(1, 1, At, B1); PG8_BAR; PG8_SCHED;
            } else {
            PG8_LDB(B0, 0, 0); PG8_SCHED; PG8_LDA(At, 0, 0); PG8_STAGE(PG8_SA(1, 1), a1 + hstep, voffA);
            PG8_WAIT_L(8); PG8_BAR; PG8_WAIT_L(0); PG8_MMA(0, 0, At, B0); PG8_BAR; PG8_SCHED;
            PG8_LDB(B1, 0, 1); PG8_STAGE(PG8_SB(0, 0), b2, voffB);
            PG8_BAR; PG8_WAIT_L(0); PG8_MMA(0, 1, At, B1); PG8_BAR;
            PG8_LDA(At, 0, 1); PG8_STAGE(PG8_SA(0, 0), a2, voffA);
            PG8_BAR; PG8_WAIT_L(0); PG8_MMA(1, 0, At, B0); PG8_BAR; PG8_SCHED;
            PG8_STAGE(PG8_SB(0, 1), b2 + hstep, voffB);
            PG8_WAIT_V(6); PG8_BAR; PG8_MMA(1, 1, At, B1); PG8_BAR;
            PG8_LDB(B0, 1, 0); PG8_SCHED; PG8_LDA(At, 1, 0); PG8_STAGE(PG8_SA(0, 1), a2 + hstep, voffA);
            PG8_WAIT_L(8); PG8_BAR; PG8_WAIT_L(0); PG8_MMA(0, 0, At, B0); PG8_BAR; PG8_SCHED;
            PG8_LDB(B1, 1, 1); PG8_STAGE(PG8_SB(1, 0), b3, voffB);
            PG8_BAR; PG8_WAIT_L(0); PG8_MMA(0, 1, At, B1); PG8_BAR;
            PG8_LDA(At, 1, 1); PG8_STAGE(PG8_SA(1, 0), a3, voffA);
            PG8_BAR; PG8_WAIT_L(0); PG8_MMA(1, 0, At, B0); PG8_BAR; PG8_SCHED;
            PG8_STAGE(PG8_SB(1, 1), b3 + hstep, voffB);
            PG8_WAIT_V(6); PG8_BAR; PG8_MMA(1, 1, At, B1); PG8_BAR;
            }
        }
        if constexpr (ALIGN_EPI) { if (wr == 0) PG8_BAR; }
        if constexpr (!Epi::AFTER_DRAIN) { if constexpr (Epi::TWOSEG) { if (cur.seg == 0) E.mid(acc, cur, wr, wc, fr, fq); else E(acc, cur, wr, wc, fr, fq); } else { E(acc, cur, wr, wc, fr, fq); } S.done(cur); }
        if (!has_next) break;
        if (!(Epi::TWOSEG && cur.seg == 0)) {
#pragma unroll
        for (int a = 0; a < 2; ++a)
#pragma unroll
            for (int b = 0; b < 2; ++b)
#pragma unroll
                for (int m = 0; m < 4; ++m)
#pragma unroll
                    for (int n = 0; n < 2; ++n) acc[a][b][m][n] = (f32x4){0.f, 0.f, 0.f, 0.f};
        }
        cur = nxt; cA = nA; cB = nB; ++ui;
        if constexpr (ALIGN_EPI) { if (wr == 1) PG8_BAR; }
    }
    PG8_WAIT_V(0);
    if constexpr (!ALIGN_EPI) { if (wr == 0) PG8_BAR; }
    PG8_BAR;
    if constexpr (Epi::AFTER_DRAIN) { E.fused(acc, cur, wr, wc, fr, fq, lds, wid, lane); S.done(cur); }
#undef PG8_SA
#undef PG8_SB
#undef PG8_STAGE
#undef PG8_LDA
#undef PG8_LDB
#undef PG8_MMA
#undef PG8_WAIT_V
#undef PG8_WAIT_L
#undef PG8_BAR
#undef PG8_SCHED
}
}
#define GAS __attribute__((address_space(1)))
#define LAS __attribute__((address_space(3)))
typedef unsigned short bf16;
typedef unsigned v4u __attribute__((ext_vector_type(4)));
typedef float f32x4 __attribute__((ext_vector_type(4)));
typedef short bf16x8 __attribute__((ext_vector_type(8)));
typedef GAS unsigned gu32;
typedef GAS unsigned long long gu64;
#define RLX_AGENT __ATOMIC_RELAXED, __HIP_MEMORY_SCOPE_AGENT
#define LDS_WAIT() asm volatile("s_waitcnt lgkmcnt(0)" ::: "memory")
#define VM_WAIT() asm volatile("s_waitcnt vmcnt(0)" ::: "memory")
__device__ __forceinline__ unsigned long long rt() { return __builtin_amdgcn_s_memrealtime(); }
__device__ __forceinline__ unsigned f2bf(float f) { unsigned u = __builtin_bit_cast(unsigned, f); return (u + 0x7fffu + ((u >> 16) & 1u)) >> 16; }
__device__ __forceinline__ unsigned pk2(float lo, float hi) { return f2bf(lo) | (f2bf(hi) << 16); }

#define XB_TMO      128
#define XB_XCNT(j)  (256  + 64 * (j))
#define XB_XSUB(j)  (1280 + 64 * (j))
#define XB_XGEN(j)  (2304 + 64 * (j))
#define XB_TOP      3328
#define XB_TOPGEN   3392
#define XCD_BAR_WORDS 3456
#define XB_SPIN_CAP (1u << 18)

__device__ __forceinline__ unsigned xb_ld(unsigned* p)              { return __hip_atomic_load(p, __ATOMIC_RELAXED, __HIP_MEMORY_SCOPE_AGENT); }
__device__ __forceinline__ unsigned xb_add(unsigned* p, unsigned v) { return __hip_atomic_fetch_add(p, v, __ATOMIC_RELAXED, __HIP_MEMORY_SCOPE_AGENT); }
__device__ __forceinline__ unsigned xb_xcc_id() { return (unsigned)__builtin_amdgcn_s_getreg((3 << 11) | 20) & 0xFu; }
#define XB_SPIN(cond, bar) do { unsigned _sp = 0; while (cond) { __builtin_amdgcn_s_sleep(1); \
    if ((++_sp & 255u) == 0u) { if (xb_ld(&(bar)[XB_TMO])) break; if (_sp > XB_SPIN_CAP) { atomicAdd(&(bar)[XB_TMO], 1u); break; } } } } while (0)

struct XcdBarrier {
    unsigned* bar; unsigned x;
    volatile LAS unsigned* st;
};

__device__ __forceinline__ XcdBarrier xcd_barrier_post(unsigned* bar, volatile LAS unsigned* st) {
    XcdBarrier b; b.bar = bar; b.x = xb_xcc_id(); b.st = st;
    if (threadIdx.x == 0) (void)xb_add(&bar[XB_XCNT(b.x)], 1u);
    return b;
}
__device__ __forceinline__ void xcd_barrier_complete(unsigned* bar, unsigned x, unsigned& nloc, unsigned& nx) {
    const unsigned G = gridDim.x * gridDim.y * gridDim.z;
    unsigned sum, cnt, mine, sp = 0u;
    for (;;) {
        sum = 0u; cnt = 0u; mine = 0u;
#pragma unroll
        for (unsigned j = 0; j < 16; ++j) { const unsigned c = xb_ld(&bar[XB_XCNT(j)]); sum += c; cnt += (c > 0u) ? 1u : 0u; mine = (j == x) ? c : mine; }
        if (sum == G) break;
        __builtin_amdgcn_s_sleep(1);
        if ((++sp & 255u) == 0u) { if (xb_ld(&bar[XB_TMO])) break; if (sp > XB_SPIN_CAP) { atomicAdd(&bar[XB_TMO], 1u); break; } }
    }
    nloc = mine > 0u ? mine : 1u; nx = cnt > 0u ? cnt : 1u;
}

__device__ __forceinline__ void xcd_barrier(const XcdBarrier& b) {
    asm volatile("s_waitcnt vmcnt(0)" ::: "memory");
    __syncthreads();
    if (threadIdx.x == 0) {
        unsigned* bar = b.bar; const unsigned bx = xb_xcc_id();
        __builtin_amdgcn_s_waitcnt(0);
        unsigned nloc = b.st[0], nx = b.st[1];
        if (nloc == 0u) { xcd_barrier_complete(bar, bx, nloc, nx); b.st[0] = nloc; b.st[1] = nx; }
        const unsigned old = xb_add(&bar[XB_XSUB(bx)], 1u);
        const unsigned gen = old / nloc;
        if (old + 1u == (gen + 1u) * nloc) {
            __builtin_amdgcn_fence(__ATOMIC_RELEASE, "agent");
            asm volatile("s_waitcnt vmcnt(0)" ::: "memory");
            const unsigned og = xb_add(&bar[XB_TOP], 1u);
            const unsigned tg = og / nx;
            if (og + 1u == (tg + 1u) * nx) xb_add(&bar[XB_TOPGEN], 1u);
            else XB_SPIN(xb_ld(&bar[XB_TOPGEN]) == tg, bar);
            __builtin_amdgcn_fence(__ATOMIC_ACQUIRE, "agent");
            xb_add(&bar[XB_XGEN(bx)], 1u);
            asm volatile("s_waitcnt vmcnt(0)" ::: "memory");
        } else {
            XB_SPIN(xb_ld(&bar[XB_XGEN(bx)]) == gen, bar);
            __builtin_amdgcn_fence(__ATOMIC_ACQUIRE, "agent");
            asm volatile("s_waitcnt vmcnt(0)" ::: "memory");
        }
    }
    __syncthreads();
}


constexpr int NWAVES = 8;
constexpr int BATCH = 16, SEQ = 2048, DM = 1024, M = BATCH * SEQ;
constexpr int NIN_SRC = 5320, NIN = 5376;
constexpr float EPS = 1e-6f;
constexpr float LOG2E = 1.4426950408889634f;

constexpr size_t MiB = 1u << 20;
constexpr size_t WS_CTL = 0, CTL_ZERO_BYTES = 64 * 1024;
constexpr size_t WS_WIN = 2 * MiB;
constexpr size_t WIN_LAYER = (size_t)NIN * DM * 2;
constexpr size_t WS_WBR = 23 * MiB;
constexpr size_t WS_WOUT = 27 * MiB;
constexpr size_t WS_WSP = 31 * MiB;
constexpr size_t WS_XN = 32 * MiB;
constexpr size_t WS_YA = 32 * MiB, WS_YB = 64 * MiB;
constexpr size_t WS_Q = 96 * MiB, WS_QI = 128 * MiB;
constexpr size_t WS_T = 96 * MiB;
constexpr size_t WS_GA = 160 * MiB, WS_U = 192 * MiB, WS_VB = 224 * MiB, WS_GB = 256 * MiB;
constexpr size_t WS_MA = 288 * MiB, WS_MB = 352 * MiB;
constexpr size_t WS_K = 416 * MiB, WS_V = 420 * MiB, WS_KI = 424 * MiB, WS_WI = 428 * MiB;
constexpr size_t WS_X1B = 432 * MiB;
constexpr size_t WS_END = 496 * MiB;
constexpr size_t TILE_ELEMS = (size_t)M * 256;
constexpr int WGM_P1 = 4, WGM_P3 = 4, WGM_P4 = 4;
constexpr int CW_BAR = 4096;

constexpr int RING_OFF = 0, RING_BYTES = 131072;
constexpr int LDSCTL_OFF = RING_BYTES, MISC_OFF = LDSCTL_OFF + 320;
constexpr int LDS_BYTES = 163840;
constexpr int L_LIST = RING_BYTES + 1024, L_BKT = L_LIST + 8192, L_BIASB = L_BKT + 2048, L_MFIX = L_BIASB + 1024;
constexpr int L_GBAR = 143872;
constexpr int L_SCR = 144384;
static_assert(L_MFIX + 16 <= L_GBAR && L_GBAR + 256 <= L_SCR && L_SCR + 8 * 2048 <= LDS_BYTES, "selection scratch");
constexpr int L_STAT = 0, L_VN = 1024, VN_LD = 160  , L_SOUT = L_VN + 128 * VN_LD * 2, SOUT_LD = 132  ;
static_assert(L_SOUT + 128 * SOUT_LD * 4 + 1536 * 4 <= RING_BYTES && L_MFIX + 16 <= LDS_BYTES, "mixer LDS map");
constexpr int VS_LD = 80;
constexpr int KS_LD = 72;
constexpr int ATT_WAVE_BYTES = 32 * KS_LD * 2 + 32 * VS_LD * 2 + 4096 + 2048;
static_assert(ATT_WAVE_BYTES <= 16384, "a wave's attention staging fits its own two score rows");

typedef float f32x16 __attribute__((ext_vector_type(16)));
typedef short s16x4 __attribute__((ext_vector_type(4)));
typedef unsigned u32x2 __attribute__((ext_vector_type(2)));
typedef unsigned u32x4 __attribute__((ext_vector_type(4)));

__device__ __forceinline__ float bf2f(bf16 v) { return __uint_as_float((unsigned)v << 16); }
__device__ __forceinline__ float wave_sum(float v) {
#pragma unroll
    for (int o = 1; o < 64; o <<= 1) v += __shfl_xor(v, o);
    return v;
}
__device__ __forceinline__ float wave_max(float v) {
#pragma unroll
    for (int o = 1; o < 64; o <<= 1) v = fmaxf(v, __shfl_xor(v, o));
    return v;
}

__device__ __forceinline__ void p0_tr_item(const float* W, int ldw, int src_col0, int nvalid, int k0, bf16* WT, int Kd, int dst_row0, LAS float* scr, int lane) {
    const int n = lane & 31;
#pragma unroll
    for (int i = 0; i < 32; ++i) { const int kk = 2 * i + (lane >> 5); scr[kk * 33 + n] = (n < nvalid) ? __builtin_nontemporal_load(W + (size_t)(k0 + kk) * ldw + src_col0 + n) : 0.f; }
    LDS_WAIT(); asm volatile("" ::: "memory");
    const int c = lane & 7;
#pragma unroll
    for (int j = 0; j < 4; ++j) { const int nn = (lane >> 3) + 8 * j; const LAS float* s = scr + (8 * c) * 33 + nn;
        v4u o; o.x = pk2(s[0 * 33], s[1 * 33]); o.y = pk2(s[2 * 33], s[3 * 33]); o.z = pk2(s[4 * 33], s[5 * 33]); o.w = pk2(s[6 * 33], s[7 * 33]);
        *(GAS v4u*)(WT + (size_t)(dst_row0 + nn) * Kd + k0 + 8 * c) = o; }
    LDS_WAIT(); asm volatile("" ::: "memory");
}
__device__ __forceinline__ void win_block_src(int vb, int& src, int& nvalid) {
    const int tile = vb >> 3, j = vb & 7; nvalid = 32;
    if (tile < 2) { const int hh = j & 3, dhi = j >> 2; src = (4 * tile + hh) * 64 + 32 * dhi; }
    else if (tile == 2) { const int hh = j & 3, dhi = j >> 2;
        if (hh == 0) src = 512 + 32 * dhi; else if (hh == 1) src = 576 + 32 * dhi; else if (hh == 2) src = 1664 + 32 * dhi; else { src = 1728; nvalid = (dhi == 0) ? 8 : 0; } }
    else { const int v = vb * 32;
        if (v < 1280) src = 1152 + (v - 768); else if (v < 1792) src = 640 + (v - 1280);
        else if (v < 3328 && !(v >= 2304 && v < 2816)) { const int tl = v >> 8, t = (tl == 7) ? 0 : (tl == 8) ? 1 : (tl == 11) ? 2 : 3, w = v & 255; src = (w < 128) ? 1736 + 128 * t + w : 2760 + 128 * t + (w - 128); }
        else if (v < 2816) src = 2248 + (v - 2304);
        else { const int t = (v - 3328) >> 8, w = (v - 3328) & 255; src = (w < 128) ? 3272 + 128 * t + w : 4296 + 128 * t + (w - 128); } }
}
__device__ __forceinline__ float wave_sum_f32_dpp(float v) {
    v += __int_as_float(__builtin_amdgcn_update_dpp(0, __float_as_int(v), 0xB1, 0xf, 0xf, true));
    v += __int_as_float(__builtin_amdgcn_update_dpp(0, __float_as_int(v), 0x4E, 0xf, 0xf, true));
    v += __int_as_float(__builtin_amdgcn_update_dpp(0, __float_as_int(v), 0x141, 0xf, 0xf, true));
    v += __int_as_float(__builtin_amdgcn_update_dpp(0, __float_as_int(v), 0x140, 0xf, 0xf, true));
    return (__int_as_float(__builtin_amdgcn_readlane(__float_as_int(v), 0)) + __int_as_float(__builtin_amdgcn_readlane(__float_as_int(v), 16))) +
           (__int_as_float(__builtin_amdgcn_readlane(__float_as_int(v), 32)) + __int_as_float(__builtin_amdgcn_readlane(__float_as_int(v), 48)));
}
__device__ __forceinline__ void rms_rows2_to_bf16(const float* xrow0, const float* xrow1, const float* g, bf16* orow0, bf16* orow1, int lane) {
    const GAS f32x4* xa = (const GAS f32x4*)xrow0 + 2 * lane; const GAS f32x4* xb = (const GAS f32x4*)xrow1 + 2 * lane; const f32x4* gr = (const f32x4*)g + 2 * lane;
    f32x4 va[4], vb[4], gg[4]; float sa = 0.f, sb = 0.f;
#pragma unroll
    for (int j = 0; j < 4; ++j) { const int o = 128 * (j >> 1) + (j & 1); va[j] = __builtin_nontemporal_load(xa + o); vb[j] = __builtin_nontemporal_load(xb + o); gg[j] = gr[o]; }
#pragma unroll
    for (int j = 0; j < 4; ++j) { sa += (va[j].x * va[j].x + va[j].y * va[j].y) + (va[j].z * va[j].z + va[j].w * va[j].w); sb += (vb[j].x * vb[j].x + vb[j].y * vb[j].y) + (vb[j].z * vb[j].z + vb[j].w * vb[j].w); }
    const float ra = 1.0f / sqrtf(wave_sum_f32_dpp(sa) * (1.0f / DM) + EPS), rb = 1.0f / sqrtf(wave_sum_f32_dpp(sb) * (1.0f / DM) + EPS);
    GAS v4u* oa = (GAS v4u*)orow0 + lane; GAS v4u* ob = (GAS v4u*)orow1 + lane;
#pragma unroll
    for (int h = 0; h < 2; ++h) { const f32x4 p0 = va[2 * h] * ra * gg[2 * h], p1 = va[2 * h + 1] * ra * gg[2 * h + 1], q0 = vb[2 * h] * rb * gg[2 * h], q1 = vb[2 * h + 1] * rb * gg[2 * h + 1];
        v4u wa, wb; wa.x = pk2(p0.x, p0.y); wa.y = pk2(p0.z, p0.w); wa.z = pk2(p1.x, p1.y); wa.w = pk2(p1.z, p1.w); wb.x = pk2(q0.x, q0.y); wb.y = pk2(q0.z, q0.w); wb.z = pk2(q1.x, q1.y); wb.w = pk2(q1.z, q1.w);
        oa[64 * h] = wa; ob[64 * h] = wb; }
}

struct Frame {
    LAS unsigned char* lds;
    int tid, lane, wave, vcu, G;
    const float *x, *norm_g, *w_in, *q_norm_g, *k_norm_g, *rel_bias, *sgu_ln_g, *sgu_ln_b, *w_spatial, *b_spatial, *w_branch, *w_out;
    float* out; unsigned char* ws;
};

__device__ __forceinline__ void p0_prologue(Frame& F0) {
    Frame F = F0; { int t = F.tid; asm volatile("" : "+v"(t)); F.tid = t; F.lane = t & 63; }
    LAS float* scr = (LAS float*)(F.lds + RING_OFF + F.wave * 16384);
    const int gw = F.vcu * NWAVES + F.wave, NGW = F.G * NWAVES;
    constexpr int I_IN = (NIN / 32) * (DM / 64);
    constexpr int I_BR = (DM / 32) * (512 / 64);
    constexpr int I_OUT = (DM / 32) * (DM / 64);
    constexpr int I_LAYER = I_IN + 2 * I_BR + I_OUT;
    for (int it = gw; it < 2 * I_LAYER; it += NGW) {
        const int l = it / I_LAYER; int r = it % I_LAYER;
        if (r < I_IN) { const int vb = r / (DM / 64), kb = r % (DM / 64); int src, nv; win_block_src(vb, src, nv);
            p0_tr_item(F.w_in + (size_t)l * DM * NIN_SRC, NIN_SRC, src, nv, 64 * kb, (bf16*)(F.ws + WS_WIN + l * WIN_LAYER), DM, 32 * vb, scr, F.lane); continue; }
        r -= I_IN;
        if (r < 2 * I_BR) { const int br = r / I_BR, q = r % I_BR, nb = q / 8, kb = q % 8;
            p0_tr_item(F.w_branch + (size_t)(l * 2 + br) * 512 * DM, DM, 32 * nb, 32, 64 * kb, (bf16*)(F.ws + WS_WBR + (size_t)(l * 2 + br) * MiB), 512, 32 * nb, scr, F.lane); continue; }
        r -= 2 * I_BR;
        { const int nb = r / 16, kb = r % 16;
            p0_tr_item(F.w_out + (size_t)l * DM * DM, DM, 32 * nb, 32, 64 * kb, (bf16*)(F.ws + WS_WOUT + (size_t)l * 2 * MiB), DM, 32 * nb, scr, F.lane); }
    }
    { bf16* wsp = (bf16*)(F.ws + WS_WSP);
      for (int i = (F.vcu * NWAVES * 64) + F.tid; i < 2 * 4 * 128 * 128; i += F.G * NWAVES * 64) { const int s = i & 127, t = (i >> 7) & 127; wsp[i] = (s <= t) ? (bf16)f2bf(F.w_spatial[i]) : (bf16)0; } }
    for (int m = 2 * gw; m < M; m += 2 * NGW) rms_rows2_to_bf16(F.x + (size_t)m * DM, F.x + (size_t)(m + 1) * DM, F.norm_g, (bf16*)(F.ws + WS_XN) + (size_t)m * DM, (bf16*)(F.ws + WS_XN) + (size_t)(m + 1) * DM, F.lane);
}
__device__ __forceinline__ void rms_rows2_b2b(const bf16* xrow0, const bf16* xrow1, const float* g, bf16* orow0, bf16* orow1, int lane) {
    const GAS v4u* xa = (const GAS v4u*)xrow0 + 2 * lane; const GAS v4u* xb = (const GAS v4u*)xrow1 + 2 * lane; const f32x4* gr = (const f32x4*)g + 4 * lane;
    const v4u a0 = xa[0], a1 = xa[1], b0 = xb[0], b1 = xb[1];
    f32x4 gg[4];
#pragma unroll
    for (int j = 0; j < 4; ++j) gg[j] = gr[j];
    float va[16], vb[16];
#define UNPK(dst, W_, o) dst[o] = pg8::bf_lo(W_.x); dst[o + 1] = pg8::bf_hi(W_.x); dst[o + 2] = pg8::bf_lo(W_.y); dst[o + 3] = pg8::bf_hi(W_.y); dst[o + 4] = pg8::bf_lo(W_.z); dst[o + 5] = pg8::bf_hi(W_.z); dst[o + 6] = pg8::bf_lo(W_.w); dst[o + 7] = pg8::bf_hi(W_.w);
    UNPK(va, a0, 0) UNPK(va, a1, 8) UNPK(vb, b0, 0) UNPK(vb, b1, 8)
#undef UNPK
    float sa = 0.f, sb = 0.f;
#pragma unroll
    for (int j = 0; j < 16; ++j) { sa = fmaf(va[j], va[j], sa); sb = fmaf(vb[j], vb[j], sb); }
    const float ra = 1.0f / sqrtf(wave_sum_f32_dpp(sa) * (1.0f / DM) + EPS), rb = 1.0f / sqrtf(wave_sum_f32_dpp(sb) * (1.0f / DM) + EPS);
    v4u oa[2], ob[2];
#pragma unroll
    for (int h = 0; h < 2; ++h) {
        oa[h].x = pk2(va[8 * h] * ra * gg[2 * h][0], va[8 * h + 1] * ra * gg[2 * h][1]); oa[h].y = pk2(va[8 * h + 2] * ra * gg[2 * h][2], va[8 * h + 3] * ra * gg[2 * h][3]);
        oa[h].z = pk2(va[8 * h + 4] * ra * gg[2 * h + 1][0], va[8 * h + 5] * ra * gg[2 * h + 1][1]); oa[h].w = pk2(va[8 * h + 6] * ra * gg[2 * h + 1][2], va[8 * h + 7] * ra * gg[2 * h + 1][3]);
        ob[h].x = pk2(vb[8 * h] * rb * gg[2 * h][0], vb[8 * h + 1] * rb * gg[2 * h][1]); ob[h].y = pk2(vb[8 * h + 2] * rb * gg[2 * h][2], vb[8 * h + 3] * rb * gg[2 * h][3]);
        ob[h].z = pk2(vb[8 * h + 4] * rb * gg[2 * h + 1][0], vb[8 * h + 5] * rb * gg[2 * h + 1][1]); ob[h].w = pk2(vb[8 * h + 6] * rb * gg[2 * h + 1][2], vb[8 * h + 7] * rb * gg[2 * h + 1][3]);
    }
    GAS v4u* pa = (GAS v4u*)orow0 + 2 * lane; GAS v4u* pb = (GAS v4u*)orow1 + 2 * lane;
    pa[0] = oa[0]; pa[1] = oa[1]; pb[0] = ob[0]; pb[1] = ob[1];
}
__device__ __forceinline__ void p5_renorm(Frame& F0, const bf16* xin, const float* g) {
    Frame F = F0; { int t = F.tid; asm volatile("" : "+v"(t)); F.tid = t; F.lane = t & 63; }
    const int gw = F.vcu * NWAVES + F.wave, NGW = F.G * NWAVES;
    for (int m = 2 * gw; m < M; m += 2 * NGW) rms_rows2_b2b(xin + (size_t)m * DM, xin + (size_t)(m + 1) * DM, g, (bf16*)(F.ws + WS_XN) + (size_t)m * DM, (bf16*)(F.ws + WS_XN) + (size_t)(m + 1) * DM, F.lane);
}

typedef short v4i16_t __attribute__((ext_vector_type(4)));
__device__ __forceinline__ s16x4 vtr(const LAS bf16* p) { return __builtin_bit_cast(s16x4, __builtin_amdgcn_ds_read_tr16_b64_v4i16((LAS v4i16_t*)p)); }
#ifndef REP_IDX
#define REP_IDX 1
#endif
#ifndef REP_SEL
#define REP_SEL 1
#endif
#ifndef REP_HIST
#define REP_HIST 1
#endif
#ifndef REP_EMIT
#define REP_EMIT 1
#endif
#ifndef REP_ATT
#define REP_ATT 1
#endif
#ifndef REP_SGU
#define REP_SGU 1
#endif
__device__ __forceinline__ void sgu_chunk(Frame& F, int r0, const bf16* VB, const bf16* U, const bf16* GB, const bf16* WsB, const float* bsp, const float* lng, const float* lnb, bf16* YB) {
    typedef float f32x2v __attribute__((ext_vector_type(2)));
    LAS f32x2v* stat = (LAS f32x2v*)(F.lds + L_STAT);
    LAS bf16* vn = (LAS bf16*)(F.lds + L_VN);
    LAS float* so = (LAS float*)(F.lds + L_SOUT);
    const int tid = F.tid, lane = F.lane;
    const int row = tid >> 2, q4 = tid & 3;
    LAS float* lnp = (LAS float*)(F.lds + L_SOUT + 128 * SOUT_LD * 4);
    { lnp[tid] = lng[tid]; lnp[512 + tid] = lnb[tid]; lnp[1024 + tid] = bsp[tid]; }
    v4u vw[16];
    {
        const v4u* p = (const v4u*)(VB + (size_t)(r0 + row) * 256) + q4;
#pragma unroll
        for (int i = 0; i < 16; ++i) vw[i] = p[(size_t)(i >> 3) * (TILE_ELEMS / 8) + 4 * (i & 7)];
    }
    f32x2v st;
    {
        float s = 0.f, ss = 0.f;
#pragma unroll
        for (int i = 0; i < 16; ++i) { const v4u w = vw[i];
            const float e0 = pg8::bf_lo(w.x), e1 = pg8::bf_hi(w.x), e2 = pg8::bf_lo(w.y), e3 = pg8::bf_hi(w.y), e4 = pg8::bf_lo(w.z), e5 = pg8::bf_hi(w.z), e6 = pg8::bf_lo(w.w), e7 = pg8::bf_hi(w.w);
            s += ((e0 + e1) + (e2 + e3)) + ((e4 + e5) + (e6 + e7));
            ss += ((e0 * e0 + e1 * e1) + (e2 * e2 + e3 * e3)) + ((e4 * e4 + e5 * e5) + (e6 * e6 + e7 * e7)); }
        s += __shfl_xor(s, 1); ss += __shfl_xor(ss, 1); s += __shfl_xor(s, 2); ss += __shfl_xor(ss, 2);
        const float mean = s * (1.0f / 512.0f); float var = ss * (1.0f / 512.0f) - mean * mean; var = var < 0.f ? 0.f : var;
        st = (f32x2v){mean, 1.0f / sqrtf(var + EPS)};
    }
    __syncthreads();
    const int wv = F.wave, tt = wv >> 1, ch = wv & 1, hh = lane >> 5, cl = lane & 31;
    const int blk = (lane >> 4) & 1, tq = (lane & 15) >> 2, tp = lane & 3;
    for (int g = 0; g < 4; ++g) {
        bf16x8 afr[8];
        {
            int cl_ = cl; asm volatile("" : "+v"(cl_));
            const bf16* wrow = WsB + (size_t)(g * 128 + 32 * tt + cl_) * 128 + 8 * hh;
#pragma unroll
            for (int ks = 0; ks < 8; ++ks) { const int kc = ks < 2 * tt + 2 ? ks : 2 * tt + 1; afr[ks] = *(const bf16x8*)(wrow + 16 * kc); }
        }
        v4u uwr[4], gwr[4];
        {
            int cs = q4 * 8;     asm volatile("" : "+v"(cs));
            const size_t tix = (size_t)(g >> 1) * TILE_ELEMS + (size_t)(r0 + row) * 256 + (g & 1) * 128 + cs;
            const v4u* up = (const v4u*)(U + tix); const v4u* gp = (const v4u*)(GB + tix);
#pragma unroll
            for (int i = 0; i < 4; ++i) { uwr[i] = up[4 * i]; } (void)gp; (void)gwr;
        }
        {
            int cs = q4 * 8;     asm volatile("" : "+v"(cs));
            const LAS f32x4* gp = (const LAS f32x4*)(lnp + 128 * g + cs); const LAS f32x4* bp = (const LAS f32x4*)(lnp + 512 + 128 * g + cs);
#pragma unroll
            for (int i = 0; i < 4; ++i) { const v4u w = vw[i]; const f32x4 g0 = gp[8 * i], g1 = gp[8 * i + 1], b0 = bp[8 * i], b1 = bp[8 * i + 1];
                f32x4 x0 = (f32x4){pg8::bf_lo(w.x), pg8::bf_hi(w.x), pg8::bf_lo(w.y), pg8::bf_hi(w.y)}, x1 = (f32x4){pg8::bf_lo(w.z), pg8::bf_hi(w.z), pg8::bf_lo(w.w), pg8::bf_hi(w.w)};
                x0 = (x0 - st.x) * st.y * g0 + b0; x1 = (x1 - st.x) * st.y * g1 + b1;
                *(LAS v4u*)(vn + row * VN_LD + cs + 32 * i) = __builtin_bit_cast(v4u, pg8::pack8(x0, x1)); }
#pragma unroll
            for (int i = 0; i < 12; ++i) vw[i] = vw[i + 4];
        }
        __syncthreads();
        {
            f32x16 acc[2];
#pragma unroll
            for (int nt = 0; nt < 2; ++nt)
#pragma unroll
                for (int r = 0; r < 16; ++r) acc[nt][r] = 0.f;
#pragma unroll
            for (int ks = 0; ks < 8; ++ks) if (ks < 2 * tt + 2) {
                const bf16x8 a = afr[ks];
#pragma unroll
                for (int nt = 0; nt < 2; ++nt) {
                    const LAS bf16* bp = vn + (16 * ks + 8 * hh + tq) * VN_LD + 64 * ch + 32 * nt + 16 * blk + 4 * tp;
                    const s16x4 r1 = vtr(bp), r2 = vtr(bp + 4 * VN_LD);
                    const bf16x8 bfr = (bf16x8){r1[0], r1[1], r1[2], r1[3], r2[0], r2[1], r2[2], r2[3]};
                    acc[nt] = __builtin_amdgcn_mfma_f32_32x32x16_bf16(a, bfr, acc[nt], 0, 0, 0);
                }
            }
#pragma unroll
            for (int nt = 0; nt < 2; ++nt)
#pragma unroll
                for (int r = 0; r < 16; ++r) { const int t = 32 * tt + (r & 3) + 8 * (r >> 2) + 4 * hh; so[t * SOUT_LD + 64 * ch + 32 * nt + cl] = acc[nt][r] + lnp[1024 + g * 128 + t]; }
        }
        __syncthreads();
        {
            int cs = q4 * 8;     asm volatile("" : "+v"(cs));
            v4u* yp = (v4u*)(YB + (size_t)(r0 + row) * 512 + 128 * g + cs);
            const LAS f32x4* sp = (const LAS f32x4*)(so + row * SOUT_LD + cs);
#pragma unroll
            for (int i = 0; i < 4; ++i) { const v4u uw = uwr[i]; const f32x4 s0 = sp[8 * i], s1 = sp[8 * i + 1];
                f32x4 y0, y1;
                y0[0] = pg8::bf_lo(uw.x) * s0[0]; y0[1] = pg8::bf_hi(uw.x) * s0[1]; y0[2] = pg8::bf_lo(uw.y) * s0[2]; y0[3] = pg8::bf_hi(uw.y) * s0[3];
                y1[0] = pg8::bf_lo(uw.z) * s1[0]; y1[1] = pg8::bf_hi(uw.z) * s1[1]; y1[2] = pg8::bf_lo(uw.w) * s1[2]; y1[3] = pg8::bf_hi(uw.w) * s1[3];
                yp[4 * i] = __builtin_bit_cast(v4u, pg8::pack8(y0, y1)); }
        }
    }
    __syncthreads();
}

constexpr unsigned KEY_NINF = 0x007FFFFFu;
__device__ __forceinline__ unsigned f2key(float s) { const unsigned u = __float_as_uint(s); return u ^ ((unsigned)((int)u >> 31) | 0x80000000u); }

struct AttnT { unsigned char* ws; };
#define AT_Q(A)  ((const bf16*)((A).ws + WS_Q))
#define AT_KN(A) ((const bf16*)((A).ws + WS_K))
#define AT_VV(A) ((const bf16*)((A).ws + WS_V))
#define AT_KI(A) ((const bf16*)((A).ws + WS_KI))
#define AT_QI(A) ((const bf16*)((A).ws + WS_QI))
#define AT_GA(A) ((const bf16*)((A).ws + WS_GA))
#define AT_WI(A) ((const float*)((A).ws + WS_WI))
#define AT_YA(A) ((bf16*)((A).ws + WS_YA))

struct AttPF { v4u k[4], v[4]; float bb[4]; };
struct AttCtx { const GAS char* kb; const GAS char* vb; const LAS unsigned short* lst0; const LAS unsigned char* bkt; const LAS float* biasb; int ng0, nu, g, hc, lane, tqb; };
__device__ __forceinline__ void att_prefetch(AttPF& S, const AttCtx& cx, int u_in) {
    {
        const int u = u_in < cx.nu ? u_in : cx.nu - 1;
        const int qn = (u >= cx.ng0) ? 1 : 0, bn = (u - (qn ? cx.ng0 : 0)) * 32;
        const LAS unsigned short* ln = cx.lst0 + qn * 256 + bn;
        const u32x2 e4 = *(const LAS u32x2*)(ln + 4 * (cx.lane >> 3));
#pragma unroll
        for (int i = 0; i < 4; ++i) { const unsigned w_ = (i < 2) ? e4.x : e4.y; const unsigned kv = ((i & 1) ? (w_ >> 16) : w_) & 0x7ffu; const unsigned off = kv * 128u + (unsigned)(cx.lane & 7) * 16u;
            S.k[i] = *(const GAS v4u*)(cx.kb + off); S.v[i] = *(const GAS v4u*)(cx.vb + off); }
        const u32x2 ki = *(const LAS u32x2*)(ln + 16 * (cx.hc >> 3) + 4 * cx.g); const int t = cx.tqb + qn;
#pragma unroll
        for (int r = 0; r < 4; ++r) { const unsigned w0 = (r < 2) ? ki.x : ki.y; const unsigned bq_ = (r & 1) ? (w0 >> 27) : ((w0 >> 11) & 31u); S.bb[r] = cx.biasb[(int)bq_ * 8 + (cx.hc & 7)]; }   (void)t;
    }
}
__device__ __forceinline__ void att_stage(const AttPF& S, const AttCtx& cx, LAS bf16* Ks, LAS bf16* Vs) {
#pragma unroll
    for (int i = 0; i < 4; ++i) { *(LAS v4u*)(Ks + (4 * (cx.lane >> 3) + i) * KS_LD + (cx.lane & 7) * 8) = S.k[i]; *(LAS v4u*)(Vs + (4 * (cx.lane >> 3) + i) * VS_LD + (cx.lane & 7) * 8) = S.v[i]; }
}
__device__ __forceinline__ void att_compute(const AttPF& S, const AttPF& N, bool stage_next, const AttCtx& cx, int u, int qi, int grp, int n, int t, const LAS bf16x8* qs, LAS bf16* Ks, LAS bf16* Vs,
                                            const LAS unsigned char* bkt, const LAS float* biasb, float SC, f32x4 (&O)[4], float& lsum) {
    const int g = cx.g, hc = cx.hc, base = grp * 32;
    asm volatile("" ::: "memory");
    bf16x8 a0[2], a1[2], qb[2];
#pragma unroll
    for (int ks = 0; ks < 2; ++ks) { a0[ks] = *(const LAS bf16x8*)(Ks + hc * KS_LD + (g + 4 * ks) * 8); a1[ks] = *(const LAS bf16x8*)(Ks + (16 + hc) * KS_LD + (g + 4 * ks) * 8); qb[ks] = qs[64 * ks]; }
    const int tq = hc >> 2, tp = hc & 3;
    bf16x8 vb[4];
#pragma unroll
    for (int nt = 0; nt < 4; ++nt) {
        const s16x4 r1 = vtr(Vs + (4 * g + tq) * VS_LD + 16 * nt + 4 * tp), r2 = vtr(Vs + (16 + 4 * g + tq) * VS_LD + 16 * nt + 4 * tp);
        vb[nt] = (bf16x8){r1[0], r1[1], r1[2], r1[3], r2[0], r2[1], r2[2], r2[3]};
    }
    asm volatile("" ::: "memory");
    if (stage_next) att_stage(N, cx, Ks, Vs);
    asm volatile("" ::: "memory");
    f32x4 C0 = (f32x4){0.f, 0.f, 0.f, 0.f}, C1 = (f32x4){0.f, 0.f, 0.f, 0.f};
    C0 = __builtin_amdgcn_mfma_f32_16x16x32_bf16(a0[0], qb[0], C0, 0, 0, 0); C0 = __builtin_amdgcn_mfma_f32_16x16x32_bf16(a0[1], qb[1], C0, 0, 0, 0);
    C1 = __builtin_amdgcn_mfma_f32_16x16x32_bf16(a1[0], qb[0], C1, 0, 0, 0); C1 = __builtin_amdgcn_mfma_f32_16x16x32_bf16(a1[1], qb[1], C1, 0, 0, 0);
    const int sub = hc >> 3;
    float P[4];
#pragma unroll
    for (int r = 0; r < 4; ++r) {
        const float cx_ = __int_as_float(__builtin_amdgcn_update_dpp(__float_as_int(C0[r]), __float_as_int(C1[r]), 0x118, 0xf, 0xC, false));
        P[r] = __builtin_amdgcn_exp2f(fmaf(cx_, SC, S.bb[r]));
    }
    if (base + 32 > n) {
#pragma unroll
        for (int r = 0; r < 4; ++r) P[r] = (base + 16 * sub + 4 * g + r < n) ? P[r] : 0.f;
    }
    lsum += (P[0] + P[1]) + (P[2] + P[3]);
    u32x4 pw; pw.x = pg8::cvt_pk_bf16(P[0], P[1]); pw.y = pg8::cvt_pk_bf16(P[2], P[3]);
    pw.z = (unsigned)__builtin_amdgcn_update_dpp(0, (int)pw.x, 0x108, 0xf, 0xf, true); pw.w = (unsigned)__builtin_amdgcn_update_dpp(0, (int)pw.y, 0x108, 0xf, 0xf, true);
    const bf16x8 pf = __builtin_bit_cast(bf16x8, pw);
#pragma unroll
    for (int nt = 0; nt < 4; ++nt) O[nt] = __builtin_amdgcn_mfma_f32_16x16x32_bf16(pf, vb[nt], O[nt], 0, 0, 0);
}
template <bool PF>
__device__ __forceinline__ void att_step(AttPF& S, const AttPF& N, const AttCtx& cx, int u, int grp, int n, const bf16x8 (&qb)[2], LAS bf16* Ks, LAS bf16* Vs, float SC, f32x4 (&O)[4], float& lsum, f32x4& C0, f32x4& C1) {
    const int g = cx.g, hc = cx.hc, base = grp * 32;
    asm volatile("" ::: "memory");
    unsigned kv[4] = {0u, 0u, 0u, 0u}; u32x2 ki = (u32x2){0u, 0u}; int tn = 0;
    if (PF) {
        const int un = (u + 3 < cx.nu) ? u + 3 : cx.nu - 1;
        const int qn = (un >= cx.ng0) ? 1 : 0, bn = (un - (qn ? cx.ng0 : 0)) * 32;
        const LAS unsigned short* ln = cx.lst0 + qn * 256 + bn;
        { const u32x2 e4 = *(const LAS u32x2*)(ln + 4 * (cx.lane >> 3)); kv[0] = e4.x; kv[1] = e4.x >> 16; kv[2] = e4.y; kv[3] = e4.y >> 16; }
        ki = *(const LAS u32x2*)(ln + 16 * (hc >> 3) + 4 * g);
        tn = cx.tqb + qn;
    }
    asm volatile("" ::: "memory");
    const int tq = hc >> 2, tp = hc & 3;
    bf16x8 vb[4];
#pragma unroll
    for (int nt = 0; nt < 4; ++nt) {
        const s16x4 r1 = vtr(Vs + (4 * g + tq) * VS_LD + 16 * nt + 4 * tp), r2 = vtr(Vs + (16 + 4 * g + tq) * VS_LD + 16 * nt + 4 * tp);
        vb[nt] = (bf16x8){r1[0], r1[1], r1[2], r1[3], r2[0], r2[1], r2[2], r2[3]};
    }
    asm volatile("" ::: "memory");
    att_stage(N, cx, Ks, Vs);
    asm volatile("" ::: "memory");
    bf16x8 a0[2], a1[2];
#pragma unroll
    for (int ks = 0; ks < 2; ++ks) { a0[ks] = *(const LAS bf16x8*)(Ks + hc * KS_LD + (g + 4 * ks) * 8); a1[ks] = *(const LAS bf16x8*)(Ks + (16 + hc) * KS_LD + (g + 4 * ks) * 8); }
    asm volatile("" ::: "memory");
    unsigned bq[4] = {0u, 0u, 0u, 0u};
    if (PF) {
#pragma unroll
        for (int i = 0; i < 4; ++i) { const unsigned off = (kv[i] & 0x7ffu) * 128u + (unsigned)(cx.lane & 7) * 16u; S.k[i] = *(const GAS v4u*)(cx.kb + off); S.v[i] = *(const GAS v4u*)(cx.vb + off); }
        bq[0] = (ki.x >> 11) & 31u; bq[1] = ki.x >> 27; bq[2] = (ki.y >> 11) & 31u; bq[3] = ki.y >> 27;
    }
    asm volatile("" ::: "memory");
    f32x4 D0 = (f32x4){0.f, 0.f, 0.f, 0.f}, D1 = (f32x4){0.f, 0.f, 0.f, 0.f};
    D0 = __builtin_amdgcn_mfma_f32_16x16x32_bf16(a0[0], qb[0], D0, 0, 0, 0); D1 = __builtin_amdgcn_mfma_f32_16x16x32_bf16(a1[0], qb[0], D1, 0, 0, 0);
    D0 = __builtin_amdgcn_mfma_f32_16x16x32_bf16(a0[1], qb[1], D0, 0, 0, 0); D1 = __builtin_amdgcn_mfma_f32_16x16x32_bf16(a1[1], qb[1], D1, 0, 0, 0);
    float bbn[4] = {0.f, 0.f, 0.f, 0.f};
    if (PF) {
#pragma unroll
        for (int r = 0; r < 4; ++r) bbn[r] = cx.biasb[(int)bq[r] * 8 + (hc & 7)];
    }
    asm volatile("" ::: "memory");
    const int sub = hc >> 3;
    float P[4];
#pragma unroll
    for (int r = 0; r < 4; ++r) {
        const float cx_ = __int_as_float(__builtin_amdgcn_update_dpp(__float_as_int(C0[r]), __float_as_int(C1[r]), 0x118, 0xf, 0xC, false));
        P[r] = __builtin_amdgcn_exp2f(fmaf(cx_, SC, S.bb[r]));
    }
    if (base + 32 > n) {
#pragma unroll
        for (int r = 0; r < 4; ++r) P[r] = (base + 16 * sub + 4 * g + r < n) ? P[r] : 0.f;
    }
    lsum += (P[0] + P[1]) + (P[2] + P[3]);
    u32x4 pw; pw.x = pg8::cvt_pk_bf16(P[0], P[1]); pw.y = pg8::cvt_pk_bf16(P[2], P[3]);
    pw.z = (unsigned)__builtin_amdgcn_update_dpp(0, (int)pw.x, 0x108, 0xf, 0xf, true); pw.w = (unsigned)__builtin_amdgcn_update_dpp(0, (int)pw.y, 0x108, 0xf, 0xf, true);
    const bf16x8 pf = __builtin_bit_cast(bf16x8, pw);
#pragma unroll
    for (int nt = 0; nt < 4; ++nt) O[nt] = __builtin_amdgcn_mfma_f32_16x16x32_bf16(pf, vb[nt], O[nt], 0, 0, 0);
    if (PF) {
#pragma unroll
        for (int r = 0; r < 4; ++r) S.bb[r] = bbn[r];
    }
    C0 = D0; C1 = D1;
}
__device__ __forceinline__ void att_finish(const AttnT& A, size_t qrow, const LAS bf16* gs, LAS float* tb, int g, int hc, f32x4 (&O)[4], float& lsum) {
    lsum += __int_as_float(__builtin_amdgcn_update_dpp(0, __float_as_int(lsum), 0x128, 0xf, 0xf, true));
    { const unsigned xi = __float_as_uint(lsum); const auto s16 = __builtin_amdgcn_permlane16_swap(xi, xi, false, false); lsum = __uint_as_float(s16[0]) + __uint_as_float(s16[1]); }
    { const unsigned xi = __float_as_uint(lsum); const auto s32 = __builtin_amdgcn_permlane32_swap(xi, xi, false, false); lsum = __uint_as_float(s32[0]) + __uint_as_float(s32[1]); }
    const int rinv = __float_as_int(lsum > 0.f ? __builtin_amdgcn_rcpf(lsum) : 0.f);
    float linv[4];
#pragma unroll
    for (int r = 0; r < 4; ++r) { const float lo = __int_as_float(__builtin_amdgcn_readlane(rinv, r)), hi = __int_as_float(__builtin_amdgcn_readlane(rinv, 4 + r)); linv[r] = (g == 1) ? hi : lo; }
    if (g < 2) {
#pragma unroll
        for (int r = 0; r < 4; ++r)
#pragma unroll
            for (int nt = 0; nt < 4; ++nt) tb[(4 * g + r) * 64 + 16 * nt + hc] = O[nt][r] * linv[r];
    }
    asm volatile("" ::: "memory");
    {
        const int ln = 16 * g + hc;
        const f32x4 o0 = *(const LAS f32x4*)(tb + 8 * ln), o1 = *(const LAS f32x4*)(tb + 8 * ln + 4);
        const v4u gw = *(const LAS v4u*)(gs + 8 * ln);
        f32x4 y0, y1;
        y0[0] = o0[0] * pg8::bf_lo(gw.x); y0[1] = o0[1] * pg8::bf_hi(gw.x); y0[2] = o0[2] * pg8::bf_lo(gw.y); y0[3] = o0[3] * pg8::bf_hi(gw.y);
        y1[0] = o1[0] * pg8::bf_lo(gw.z); y1[1] = o1[1] * pg8::bf_hi(gw.z); y1[2] = o1[2] * pg8::bf_lo(gw.w); y1[3] = o1[3] * pg8::bf_hi(gw.w);
        *(GAS v4u*)(AT_YA(A) + qrow * 512 + 8 * ln) = __builtin_bit_cast(v4u, pg8::pack8(y0, y1));
    }
    asm volatile("" ::: "memory");
#pragma unroll
    for (int nt = 0; nt < 4; ++nt) O[nt] = (f32x4){0.f, 0.f, 0.f, 0.f};
    lsum = 0.f;
}
__device__ __forceinline__ unsigned wave_sum_u32(unsigned v) {
    v += (unsigned)__builtin_amdgcn_update_dpp(0, (int)v, 0xB1, 0xf, 0xf, true);
    v += (unsigned)__builtin_amdgcn_update_dpp(0, (int)v, 0x4E, 0xf, 0xf, true);
    v += (unsigned)__builtin_amdgcn_update_dpp(0, (int)v, 0x141, 0xf, 0xf, true);
    v += (unsigned)__builtin_amdgcn_update_dpp(0, (int)v, 0x140, 0xf, 0xf, true);
    return (unsigned)__builtin_amdgcn_readlane((int)v, 0) + (unsigned)__builtin_amdgcn_readlane((int)v, 16) + (unsigned)__builtin_amdgcn_readlane((int)v, 32) + (unsigned)__builtin_amdgcn_readlane((int)v, 48);
}
__device__ __forceinline__ int wave_max_i32(int v) {
    v = max(v, __builtin_amdgcn_update_dpp(v, v, 0xB1, 0xf, 0xf, false)); v = max(v, __builtin_amdgcn_update_dpp(v, v, 0x4E, 0xf, 0xf, false));
    v = max(v, __builtin_amdgcn_update_dpp(v, v, 0x141, 0xf, 0xf, false)); v = max(v, __builtin_amdgcn_update_dpp(v, v, 0x140, 0xf, 0xf, false));
    return max(max(__builtin_amdgcn_readlane(v, 0), __builtin_amdgcn_readlane(v, 16)), max(__builtin_amdgcn_readlane(v, 32), __builtin_amdgcn_readlane(v, 48)));
}
__device__ __forceinline__ unsigned lanes_below(unsigned long long m) { return __builtin_amdgcn_mbcnt_hi((unsigned)(m >> 32), __builtin_amdgcn_mbcnt_lo((unsigned)m, 0u)); }
__device__ __forceinline__ void select_bisect(const float (&s)[32], float& Ts, unsigned& tieneed) {
    unsigned Tk = 0u; bool done = false;
    for (int bit = 31; bit >= 0; --bit) {
        const unsigned cand = Tk | (1u << bit);
        unsigned c = 0u;
#pragma unroll
        for (int i = 0; i < 32; ++i) c += (f2key(s[i]) >= cand) ? 1u : 0u;
        c = wave_sum_u32(c);
        if (c >= 256u) Tk = cand;
        if (c == 256u) { done = true; break; }
    }
    unsigned kmin = 0xffffffffu; unsigned cgt = 0u;
#pragma unroll
    for (int i = 0; i < 32; ++i) { const unsigned k = f2key(s[i]); kmin = (k >= Tk && k < kmin) ? k : kmin; }
    kmin = ~(unsigned)wave_max_i32((int)(~kmin ^ 0x80000000u)) ^ 0x80000000u;
#pragma unroll
    for (int i = 0; i < 32; ++i) cgt += (f2key(s[i]) > kmin) ? 1u : 0u;
    cgt = wave_sum_u32(cgt);
    const unsigned u = (kmin & 0x80000000u) ? (kmin ^ 0x80000000u) : ~kmin;
    Ts = __uint_as_float(u); tieneed = 256u - cgt; (void)done;
}
__device__ __forceinline__ bool select_hist(const float (&s)[32], const int kmax, LAS unsigned char* scr, const int lane, float& Ts, unsigned& tieneed) {
    int mxi = (int)0x80000000;
#pragma unroll
    for (int i = 0; i < 32; ++i) mxi = max(mxi, __float_as_int(s[i]));
    const float mx = __int_as_float(wave_max_i32(mxi));
    if (!(mx > 0.f && mx < 1e30f)) return false;
    const float inv = 128.0f * __builtin_amdgcn_rcpf(mx);
    LAS unsigned* hist = (LAS unsigned*)scr;
    LAS float* candS = (LAS float*)(scr + 1024);
    *(LAS v4u*)(hist + 4 * lane) = (v4u){0u, 0u, 0u, 0u};
    asm volatile("" ::: "memory");
#pragma unroll
    for (int gi = 0; gi < 4; ++gi) {
        if (512 * gi < kmax) {
#pragma unroll
            for (int i = 8 * gi; i < 8 * gi + 8; ++i) { const int b = (int)__builtin_amdgcn_fmed3f(fmaf(s[i], inv, 128.0f), 0.0f, 255.0f);
                if (64 * i + lane < kmax) __hip_atomic_fetch_add(hist + b, 1u, __ATOMIC_RELAXED, __HIP_MEMORY_SCOPE_WORKGROUP); }
        }
    }
    asm volatile("" ::: "memory");
    const v4u hv = *(const LAS v4u*)(hist + 252 - 4 * lane);
    const unsigned v = (hv.x + hv.y) + (hv.z + hv.w);
    unsigned x = v;
    x += (unsigned)__builtin_amdgcn_update_dpp(0, (int)x, 0x111, 0xf, 0xf, true);
    x += (unsigned)__builtin_amdgcn_update_dpp(0, (int)x, 0x112, 0xf, 0xf, true);
    x += (unsigned)__builtin_amdgcn_update_dpp(0, (int)x, 0x114, 0xf, 0xf, true);
    x += (unsigned)__builtin_amdgcn_update_dpp(0, (int)x, 0x118, 0xf, 0xf, true);
    const unsigned r0 = (unsigned)__builtin_amdgcn_readlane((int)x, 15), r1 = (unsigned)__builtin_amdgcn_readlane((int)x, 31), r2 = (unsigned)__builtin_amdgcn_readlane((int)x, 47);
    const int row = lane >> 4;
    x += (row >= 1 ? r0 : 0u) + (row >= 2 ? r1 : 0u) + (row >= 3 ? r2 : 0u);
    const unsigned long long mge = __ballot(x >= 256u);
    if (mge == 0ull) return false;
    const int L = (int)__builtin_ctzll(mge);
    unsigned above = (unsigned)__builtin_amdgcn_readlane((int)(x - v), L);
    const unsigned h3 = (unsigned)__builtin_amdgcn_readlane((int)hv.w, L), h2 = (unsigned)__builtin_amdgcn_readlane((int)hv.z, L), h1 = (unsigned)__builtin_amdgcn_readlane((int)hv.y, L), h0 = (unsigned)__builtin_amdgcn_readlane((int)hv.x, L);
    int B; unsigned inB;
    if (above + h3 >= 256u) { B = 255 - 4 * L; inB = h3; }
    else { above += h3;
        if (above + h2 >= 256u) { B = 254 - 4 * L; inB = h2; }
        else { above += h2;
            if (above + h1 >= 256u) { B = 253 - 4 * L; inB = h1; }
            else { above += h1; B = 252 - 4 * L; inB = h0; } } }
    if (inB > 64u || B == 0) return false;
    unsigned cb = 0u;
#pragma unroll
    for (int gi = 0; gi < 4; ++gi) {
        if (512 * gi < kmax) {
#pragma unroll
            for (int i = 8 * gi; i < 8 * gi + 8; ++i) {
                const int b = (int)__builtin_amdgcn_fmed3f(fmaf(s[i], inv, 128.0f), 0.0f, 255.0f);
                const bool eq = (b == B);
                const unsigned long long me = __ballot(eq);
                candS[eq ? (cb + lanes_below(me)) : (64u + lane)] = s[i];
                cb += (unsigned)__popcll(me);
            }
        }
    }
    asm volatile("" ::: "memory");
    const float c = (lane < (int)inB) ? candS[lane] : -INFINITY;
    unsigned rank = 0u;
    for (int j = 0; j < (int)inB; ++j) { const float cj = __int_as_float(__builtin_amdgcn_readlane(__float_as_int(c), j)); rank += ((cj > c) || (cj == c && j < lane)) ? 1u : 0u; }
    const unsigned need = 256u - above;
    const unsigned long long mt = __ballot(lane < (int)inB && rank == need - 1u);
    if (mt == 0ull) return false;
    const int lt = (int)__builtin_ctzll(mt);
    Ts = __int_as_float(__builtin_amdgcn_readlane(__float_as_int(c), lt));
    tieneed = (unsigned)__popcll(__ballot(lane < (int)inB && c == Ts && rank < need));
    if (tieneed == (unsigned)__popcll(__ballot(lane < (int)inB && c == Ts))) tieneed = 4096u;
    return true;
}
__device__ __forceinline__ unsigned select_emit(const float (&s)[32], const int kmax, const float Ts, const unsigned tieneed, LAS unsigned short* lst, LAS unsigned short* dump, const int lane) {
    unsigned n = 0u;
    const int dofs = (int)(dump - lst) + lane;
    if (tieneed >= 4096u) {
#pragma unroll
        for (int gi = 0; gi < 4; ++gi) {
            if (512 * gi < kmax) {
#pragma unroll
                for (int i = 8 * gi; i < 8 * gi + 8; ++i) {
                    const bool sel = s[i] >= Ts;
                    const unsigned long long ms = __ballot(sel);
                    const unsigned pos = n + lanes_below(ms);
                    lst[(sel && pos < 256u) ? (int)pos : dofs] = (unsigned short)(64 * i + lane);
                    n += (unsigned)__popcll(ms);
                }
            }
        }
    } else {
        unsigned tb = 0u;
#pragma unroll
        for (int gi = 0; gi < 4; ++gi) {
            if (512 * gi < kmax) {
#pragma unroll
                for (int i = 8 * gi; i < 8 * gi + 8; ++i) {
                    const bool eq = s[i] == Ts, gt = s[i] > Ts;
                    const unsigned long long me = __ballot(eq);
                    const bool sel = gt || (eq && tb + lanes_below(me) < tieneed); tb += (unsigned)__popcll(me);
                    const unsigned long long ms = __ballot(sel);
                    const unsigned pos = n + lanes_below(ms);
                    lst[(sel && pos < 256u) ? (int)pos : dofs] = (unsigned short)(64 * i + lane);
                    n += (unsigned)__popcll(ms);
                }
            }
        }
    }
    n = n > 256u ? 256u : n;
    lst[(lane < 32 && n + lane < 256u) ? (int)(n + lane) : dofs] = 0;
    return n;
}

__device__ __forceinline__ unsigned select_emit_scan(const float (&s)[32], const int kmax, const float Ts, LAS unsigned short* lst, LAS unsigned short* dump, const int lane) {
    unsigned mask = 0u;
#pragma unroll
    for (int gi = 0; gi < 4; ++gi) {
        if (512 * gi < kmax) {
#pragma unroll
            for (int i = 8 * gi; i < 8 * gi + 8; ++i) mask = (mask << 1) | ((s[i] >= Ts) ? 1u : 0u);
        } else mask <<= 8;
    }
    const unsigned cnt = (unsigned)__popc(mask);
    unsigned x = cnt;
    x += (unsigned)__builtin_amdgcn_update_dpp(0, (int)x, 0x111, 0xf, 0xf, true);
    x += (unsigned)__builtin_amdgcn_update_dpp(0, (int)x, 0x112, 0xf, 0xf, true);
    x += (unsigned)__builtin_amdgcn_update_dpp(0, (int)x, 0x114, 0xf, 0xf, true);
    x += (unsigned)__builtin_amdgcn_update_dpp(0, (int)x, 0x118, 0xf, 0xf, true);
    const unsigned r0 = (unsigned)__builtin_amdgcn_readlane((int)x, 15), r1 = (unsigned)__builtin_amdgcn_readlane((int)x, 31), r2 = (unsigned)__builtin_amdgcn_readlane((int)x, 47), r3 = (unsigned)__builtin_amdgcn_readlane((int)x, 63);
    const int row = lane >> 4;
    x += (row >= 1 ? r0 : 0u) + (row >= 2 ? r1 : 0u) + (row >= 3 ? r2 : 0u);
    unsigned n = ((r0 + r1) + (r2 + r3));
    const unsigned base = x - cnt;
    const int maxc = wave_max_i32((int)cnt);
    const int dofs = (int)(dump - lst) + lane;
    unsigned mk = mask;
    for (int k = 0; k < maxc; ++k) {
        const int i = __builtin_clz(mk | 1u);
        const bool ok = (unsigned)k < cnt && base + (unsigned)k < 256u;
        lst[ok ? (int)(base + (unsigned)k) : dofs] = (unsigned short)(64 * i + lane);
        mk &= ~(0x80000000u >> i);
    }
    n = n > 256u ? 256u : n;
    lst[(lane < 32 && n + lane < 256u) ? (int)(n + lane) : dofs] = 0;
    return n;
}

__device__ __forceinline__ unsigned lane_prefix_incl(unsigned v, const int lane, unsigned& tot) {
    unsigned x = v;
    x += (unsigned)__builtin_amdgcn_update_dpp(0, (int)x, 0x111, 0xf, 0xf, true);
    x += (unsigned)__builtin_amdgcn_update_dpp(0, (int)x, 0x112, 0xf, 0xf, true);
    x += (unsigned)__builtin_amdgcn_update_dpp(0, (int)x, 0x114, 0xf, 0xf, true);
    x += (unsigned)__builtin_amdgcn_update_dpp(0, (int)x, 0x118, 0xf, 0xf, true);
    const unsigned r0 = (unsigned)__builtin_amdgcn_readlane((int)x, 15), r1 = (unsigned)__builtin_amdgcn_readlane((int)x, 31), r2 = (unsigned)__builtin_amdgcn_readlane((int)x, 47), r3 = (unsigned)__builtin_amdgcn_readlane((int)x, 63);
    const int row = lane >> 4;
    x += (row >= 1 ? r0 : 0u) + (row >= 2 ? r1 : 0u) + (row >= 3 ? r2 : 0u);
    tot = (r0 + r1) + (r2 + r3);
    return x;
}
__device__ __forceinline__ float vmax_raw(float a, float b) { float r; asm("v_max_f32 %0, %1, %2" : "=v"(r) : "v"(a), "v"(b)); return r; }
__device__ __forceinline__ float wave_max_f32(float v) {
    v = vmax_raw(v, __int_as_float(__builtin_amdgcn_update_dpp(__float_as_int(v), __float_as_int(v), 0xB1, 0xf, 0xf, false))); v = vmax_raw(v, __int_as_float(__builtin_amdgcn_update_dpp(__float_as_int(v), __float_as_int(v), 0x4E, 0xf, 0xf, false)));
    v = vmax_raw(v, __int_as_float(__builtin_amdgcn_update_dpp(__float_as_int(v), __float_as_int(v), 0x141, 0xf, 0xf, false))); v = vmax_raw(v, __int_as_float(__builtin_amdgcn_update_dpp(__float_as_int(v), __float_as_int(v), 0x140, 0xf, 0xf, false)));
    const int a = __float_as_int(v);
    return fmaxf(fmaxf(__int_as_float(__builtin_amdgcn_readlane(a, 0)), __int_as_float(__builtin_amdgcn_readlane(a, 16))), fmaxf(__int_as_float(__builtin_amdgcn_readlane(a, 32)), __int_as_float(__builtin_amdgcn_readlane(a, 48))));
}
#define CLS_BIT(m, f, th) asm("v_cmp_ge_f32 vcc, %1, %2\n\tv_addc_co_u32 %0, vcc, %0, %0, vcc" : "+v"(m) : "v"(f), "v"(th) : "vcc")
template <int NB>
__device__ __forceinline__ bool hist_boundary(const LAS unsigned* hist, const int lane, const unsigned above0, int& B, unsigned& above, unsigned& inB) {
    constexpr int PER = NB / 64;
    unsigned h[PER];
#pragma unroll
    for (int q = 0; q < PER / 4; ++q) { const v4u w = *(const LAS v4u*)(hist + NB - PER * (lane + 1) + 4 * q); h[4 * q] = w.x; h[4 * q + 1] = w.y; h[4 * q + 2] = w.z; h[4 * q + 3] = w.w; }
    unsigned v = 0u;
#pragma unroll
    for (int q = 0; q < PER; ++q) v += h[q];
    unsigned tot;
    const unsigned x = lane_prefix_incl(v, lane, tot) + above0;
    const unsigned long long mge = __ballot(x >= 256u);
    if (mge == 0ull) return false;
    const int L = (int)__builtin_ctzll(mge);
    above = (unsigned)__builtin_amdgcn_readlane((int)(x - v), L);
    B = NB - PER * (L + 1); inB = 0u;
    bool found = false;
#pragma unroll
    for (int q = PER - 1; q >= 0; --q) {
        const unsigned hq = (unsigned)__builtin_amdgcn_readlane((int)h[q], L);
        if (!found) { if (above + hq >= 256u) { B = NB - PER * (L + 1) + q; inB = hq; found = true; } else above += hq; }
    }
    return found;
}
#ifndef REP_FB
#define REP_FB 1
#endif
#ifndef REP_FC
#define REP_FC 1
#endif
#ifndef REP_FE
#define REP_FE 1
#endif
#define SEL_FOR_FULL(...) \
    _Pragma("unroll") for (int gi = 0; gi < 4; ++gi) { \
        if (8 * (gi + 1) <= nfull) { _Pragma("unroll") for (int i = 8 * gi; i < 8 * gi + 8; ++i) { __VA_ARGS__ } } \
        else if (8 * gi < nfull) { _Pragma("unroll") for (int i = 8 * gi; i < 8 * gi + 8; ++i) { if (i < nfull) { __VA_ARGS__ } } } }
__device__ __forceinline__ unsigned select_fused(const float (&s)[32], const int klim_in, const LAS unsigned* srow, LAS unsigned char* scr, const int lane, LAS unsigned short* lst) {
    const unsigned FAIL = 0xffffffffu;
    const int klim = __builtin_amdgcn_readfirstlane(klim_in);
    const int nfull = klim >> 6, prem = klim & 63, ip = nfull < 31 ? nfull : 31;
    const bool pv = lane < prem;
    const float sp = pv ? __uint_as_float(srow[64 * ip]) : -INFINITY;
    float mxl = sp, mnl = pv ? sp : INFINITY;
    SEL_FOR_FULL( mxl = fmaxf(mxl, s[i]); mnl = fminf(mnl, s[i]); )
    const float mx = wave_max_f32(mxl), mn = -wave_max_f32(-mnl);
    const float range = mx - mn;
    if (!(range > 0.f && range < 1e30f)) return FAIL;
    const float inv = 511.0f * __builtin_amdgcn_rcpf(range);
    const float c0 = fmaf(-mn, inv, 0.5f);
    const float fp = fmaf(sp, inv, c0);
    LAS unsigned* hist = (LAS unsigned*)scr;
    LAS unsigned* hb = hist;
    LAS float* candS = (LAS float*)lst;
    LAS unsigned short* dump = (LAS unsigned short*)scr;
    int B; unsigned above, inB;
    for (int rfb = 0; rfb < REP_FB; ++rfb) {
    asm volatile("" ::: "memory");
    *(LAS v4u*)(hist + 4 * lane) = (v4u){0u, 0u, 0u, 0u}; *(LAS v4u*)(hist + 256 + 4 * lane) = (v4u){0u, 0u, 0u, 0u};
    asm volatile("" ::: "memory");
    SEL_FOR_FULL( const int b = (int)__builtin_amdgcn_fmed3f(fmaf(s[i], inv, c0), 0.0f, 511.0f); __hip_atomic_fetch_add(hb + b, 1u, __ATOMIC_RELAXED, __HIP_MEMORY_SCOPE_WORKGROUP); )
    if (pv) { const int b = (int)__builtin_amdgcn_fmed3f(fp, 0.0f, 511.0f); __hip_atomic_fetch_add(hb + b, 1u, __ATOMIC_RELAXED, __HIP_MEMORY_SCOPE_WORKGROUP); }
    asm volatile("" ::: "memory");
    if (!hist_boundary<512>(hist, lane, 0u, B, above, inB)) return FAIL;
    }
    float thge = (float)B, thgt = (float)(B + 1);
    if (B == 0) thge = -1.0f;
    if (B == 511) thgt = 2048.0f;
    if (inB > 64u) {
        const float fB = (float)B, c1 = -256.0f * fB;
        asm volatile("" ::: "memory");
        *(LAS v4u*)(hist + 4 * lane) = (v4u){0u, 0u, 0u, 0u}; *(LAS v4u*)(hist + 256 + 4 * lane) = (v4u){0u, 0u, 0u, 0u};
        asm volatile("" ::: "memory");
        SEL_FOR_FULL( const float f = fmaf(s[i], inv, c0); const int b = (int)__builtin_amdgcn_fmed3f(fmaf(f, 256.0f, c1), 0.0f, 255.0f);
                      if (f >= thge && f < thgt) __hip_atomic_fetch_add(hb + b, 1u, __ATOMIC_RELAXED, __HIP_MEMORY_SCOPE_WORKGROUP); )
        { const int b = (int)__builtin_amdgcn_fmed3f(fmaf(fp, 256.0f, c1), 0.0f, 255.0f); if (fp >= thge && fp < thgt) __hip_atomic_fetch_add(hb + b, 1u, __ATOMIC_RELAXED, __HIP_MEMORY_SCOPE_WORKGROUP); }
        asm volatile("" ::: "memory");
        int B2; unsigned above2, inB2;
        if (!hist_boundary<256>(hist, lane, above, B2, above2, inB2)) return FAIL;
        if (inB2 > 64u) return FAIL;
        above = above2; inB = inB2;
        if (B2 > 0) thge = fB + (float)B2 * 0.00390625f;
        if (B2 < 255) thgt = fB + (float)(B2 + 1) * 0.00390625f;
    }
    unsigned mgt = 0u, mgeq = 0u;
    for (int rfc = 0; rfc < REP_FC; ++rfc) { mgt = 0u; mgeq = 0u; asm volatile("" : "+v"(thge), "+v"(thgt));
    SEL_FOR_FULL( const float f = fmaf(s[i], inv, c0); CLS_BIT(mgt, f, thgt); CLS_BIT(mgeq, f, thge); )
    }
    { const int sh = (32 - nfull) & 31; if (nfull < 32) { mgt <<= sh; mgeq <<= sh; }
      const unsigned bitp = 0x80000000u >> ip; mgt |= (fp >= thgt) ? bitp : 0u; mgeq |= (fp >= thge) ? bitp : 0u; }
    const unsigned meq = mgeq & ~mgt;
    const unsigned cnte = (unsigned)__popc(meq);
    unsigned tote;
    const unsigned ebase = lane_prefix_incl(cnte, lane, tote) - cnte;
    if (tote != inB) return FAIL;
    const int maxe = wave_max_i32((int)cnte);
    float cv0 = -INFINITY, cv1 = -INFINITY; unsigned cb0 = 0u, cb1 = 0u;
    {
        unsigned mk = meq;
        for (int k = 0; k < maxe; ++k) {
            const int i = __builtin_clz(mk | 1u);
            const float sv = __uint_as_float(srow[64 * i]);
            const bool okk = (unsigned)k < cnte;
            const unsigned bit = 0x80000000u >> i;
            candS[okk ? (int)(ebase + (unsigned)k) : (64 + lane)] = sv;
            if (k == 0) { cv0 = okk ? sv : -INFINITY; cb0 = bit; }
            if (k == 1) { cv1 = okk ? sv : -INFINITY; cb1 = bit; }
            mk &= ~bit;
        }
    }
    asm volatile("" ::: "memory");
    const bool cvalid = lane < (int)inB;
    const float c = cvalid ? candS[lane] : -INFINITY;
    unsigned rgt = 0u;
    for (int j = 0; j < (int)inB; ++j) { const float cj = __int_as_float(__builtin_amdgcn_readlane(__float_as_int(c), j)); rgt += (cj > c) ? 1u : 0u; }
    const unsigned need = 256u - above;
    const float Ts = -wave_max_f32((cvalid && rgt < need) ? -c : -INFINITY);
    if (!(Ts > -INFINITY)) return FAIL;
    if ((unsigned)__popcll(__ballot(cvalid && c >= Ts)) != need) return FAIL;
    unsigned msel = mgt | ((cv0 >= Ts) ? cb0 : 0u) | ((cv1 >= Ts) ? cb1 : 0u);
    if (maxe > 2) {
        unsigned mk = meq & ~(cb0 | cb1);
        for (int k = 2; k < maxe; ++k) {
            const int i = __builtin_clz(mk | 1u);
            const float sv = __uint_as_float(srow[64 * i]);
            const unsigned bit = 0x80000000u >> i;
            msel |= ((unsigned)k < cnte && sv >= Ts) ? bit : 0u;
            mk &= ~bit;
        }
    }
    unsigned n;
    for (int rfe = 0; rfe < REP_FE; ++rfe) {
    asm volatile("" : "+v"(msel));
    const unsigned cnt = (unsigned)__popc(msel);
    const unsigned base = lane_prefix_incl(cnt, lane, n) - cnt;
    if (n > 256u) return FAIL;
    const int dofs = (int)(dump - lst) + lane;
    {
        unsigned mk = msel;
        LAS unsigned short* wp = lst + base;
        while (mk != 0u) {
            const int i = __builtin_clz(mk);
            *wp++ = (unsigned short)(64 * i + lane);
            mk &= ~(0x80000000u >> i);
        }
    }
    n = n > 256u ? 256u : n;
    lst[(lane < 32 && n + lane < 256u) ? (int)(n + lane) : dofs] = 0;
    }
    return n;
}

constexpr int GW = 2, NRT = GW / 2, GQ = 2 * GW;
constexpr int RD = 4;
struct SweepOps { bf16x8 aq[NRT][4]; float wA[NRT][8], wB[NRT][8]; bf16x8 bt[RD][4]; };
__device__ __forceinline__ void sweep_load(SweepOps& P, const AttnT& A, const int b, const int t0, const int wg, const int lane_in) {
    int lane = lane_in; asm volatile("" : "+v"(lane));
    const size_t rb = (size_t)b * SEQ;
    const int H = lane >> 5, c = lane & 31, tmaxI = (t0 + GQ - 1) >> 5;
    const int ql = (c >> 4) + 2 * ((c >> 2) & 1), hd = (c & 3) + 4 * ((c >> 3) & 1);
#pragma unroll
    for (int rt = 0; rt < NRT; ++rt) {
        const GAS bf16* qp = (const GAS bf16*)(AT_QI(A) + (size_t)(hd >> 2) * TILE_ELEMS + (rb + t0 + 4 * rt + ql) * 256 + (hd & 3) * 64 + 8 * H);
#pragma unroll
        for (int ks = 0; ks < 4; ++ks) P.aq[rt][ks] = *(const GAS bf16x8*)(qp + 16 * ks);
        const GAS f32x4* wp = (const GAS f32x4*)(AT_WI(A) + (rb + t0 + 4 * rt + 2 * H) * 8); const f32x4 x0 = wp[0], x1 = wp[1], y0 = wp[2], y1 = wp[3];
#pragma unroll
        for (int i = 0; i < 4; ++i) { P.wA[rt][i] = x0[i]; P.wA[rt][4 + i] = x1[i]; P.wB[rt][i] = y0[i]; P.wB[rt][4 + i] = y1[i]; }
    }
    const GAS bf16* kp = (const GAS bf16*)(AT_KI(A) + ((size_t)H * M + rb + c) * 8);
#define IDX_LOAD0(dst, tl) do { const int tl_ = (tl) <= tmaxI ? (tl) : tmaxI;     \
        _Pragma("unroll") for (int ks = 0; ks < 4; ++ks) dst[ks] = *(const GAS bf16x8*)(kp + ((size_t)(2 * ks) * M + 32 * tl_) * 8); } while (0)
#pragma unroll
    for (int j = 0; j < RD; ++j) IDX_LOAD0(P.bt[j], wg + j * GW);
#undef IDX_LOAD0
}
__device__ __forceinline__ void grp_barrier(LAS unsigned* ctr, unsigned& gen, const int lane) {
    asm volatile("s_waitcnt lgkmcnt(0)" ::: "memory");
    gen += (unsigned)GW;
    if (lane == 0) __hip_atomic_fetch_add(ctr, 1u, __ATOMIC_RELAXED, __HIP_MEMORY_SCOPE_WORKGROUP);
    while ((unsigned)__builtin_amdgcn_readfirstlane((int)*(volatile LAS unsigned*)ctr) < gen) __builtin_amdgcn_s_sleep(1);
    asm volatile("" ::: "memory");
}
__device__ __forceinline__ void attn_item16(const AttnT& A, const int b, const int t0, const int b_next, const int t0_next, SweepOps& P, LAS unsigned char* lds, const int wave, const int lane_in, LAS unsigned* gctr, unsigned& ggen) {
    const int grp = wave / GW, wg = wave % GW;
    const size_t rb = (size_t)b * SEQ;
    LAS unsigned* sc = (LAS unsigned*)lds;
    LAS unsigned short* lists = (LAS unsigned short*)(lds + L_LIST);
    const LAS unsigned char* bkt = lds + L_BKT; const LAS float* biasb = (const LAS float*)(lds + L_BIASB);
    const int tmaxI = (t0 + GQ - 1) >> 5;
    for (int repi = 0; repi < REP_IDX; ++repi) {
    {
        int lane = lane_in; asm volatile("" : "+v"(lane));
        const int H = lane >> 5, c = lane & 31;
        const GAS bf16* kp = (const GAS bf16*)(AT_KI(A) + ((size_t)H * M + rb + c) * 8);
        LAS unsigned* scA = sc + (GQ * grp + 2 * H) * 2048 + c;
#define IDX_LOAD(dst, tl) do { const int tl_ = (tl) <= tmaxI ? (tl) : tmaxI; _Pragma("unroll") for (int ks = 0; ks < 4; ++ks) dst[ks] = *(const GAS bf16x8*)(kp + ((size_t)(2 * ks) * M + 32 * tl_) * 8); } while (0)
        for (int tile0 = wg; tile0 <= tmaxI; tile0 += RD * GW) {
#pragma unroll
            for (int j = 0; j < RD; ++j) {
                const int tile = tile0 + j * GW;
                if (tile <= tmaxI) {
                    const int kk = 32 * tile + c;
#pragma unroll
                    for (int rt = 0; rt < NRT; ++rt) {
                        f32x16 D;
#pragma unroll
                        for (int r = 0; r < 16; ++r) D[r] = 0.f;
#pragma unroll
                        for (int ks = 0; ks < 4; ++ks) D = __builtin_amdgcn_mfma_f32_32x32x16_bf16(P.aq[rt][ks], P.bt[j][ks], D, 0, 0, 0);
                        float sA = 0.f, sB = 0.f;
#pragma unroll
                        for (int h = 0; h < 8; ++h) { const int da = __float_as_int(D[h]), db = __float_as_int(D[8 + h]);
                            sA = fmaf(P.wA[rt][h], __int_as_float(da > 0 ? da : 0), sA); sB = fmaf(P.wB[rt][h], __int_as_float(db > 0 ? db : 0), sB); }
                        const int tqa = t0 + 4 * rt + 2 * H;
                        if (kk > tqa) sA = -INFINITY;
                        if (kk > tqa + 1) sB = -INFINITY;
                        scA[(4 * rt) * 2048 + 32 * tile] = __float_as_uint(sA); scA[(4 * rt + 1) * 2048 + 32 * tile] = __float_as_uint(sB);
                    }
                }
                IDX_LOAD(P.bt[j], tile + RD * GW);
            }
        }
#undef IDX_LOAD
    }
    grp_barrier(gctr, ggen, lane_in);
    }
    int lane = lane_in; asm volatile("" : "+v"(lane));
    LAS unsigned short* lst0 = lists + (2 * wave) * 256;
    unsigned n0, n1;
    const int tqb = t0 + 2 * wg;
    bf16x8 qv[2][2]; v4u gav[2];
    {
        const int g_ = lane >> 4, hc_ = lane & 15;
#pragma unroll
        for (int qq = 0; qq < 2; ++qq) {
#pragma unroll
            for (int ks = 0; ks < 2; ++ks) { qv[qq][ks] = (bf16x8){0, 0, 0, 0, 0, 0, 0, 0}; if (hc_ < 8) qv[qq][ks] = *(const GAS bf16x8*)(AT_Q(A) + (rb + tqb + qq) * 512 + hc_ * 64 + 32 * ks + 8 * g_); }
            const int hq = lane >> 3;
            gav[qq] = *(const GAS v4u*)(AT_GA(A) + (size_t)(hq >> 2) * TILE_ELEMS + (rb + tqb + qq) * 256 + (hq & 3) * 64 + (lane & 7) * 8);
        }
    }
    AttPF S0, S1, S2;
    AttCtx cx; cx.kb = (const GAS char*)(AT_KN(A) + rb * 64); cx.vb = (const GAS char*)(AT_VV(A) + rb * 64); cx.lst0 = lst0; cx.bkt = bkt; cx.biasb = biasb; cx.g = lane >> 4; cx.hc = lane & 15; cx.lane = lane; cx.tqb = tqb;
    for (int repsel = 0; repsel < REP_SEL; ++repsel)
    {
        const int kmax = 32 * (tmaxI + 1);
        LAS unsigned char* scr = lds + L_SCR + wave * 2048;
#pragma unroll 1
        for (int q = 0; q < 2; ++q) {
            float s[32];
            const LAS unsigned* s0 = sc + (2 * wave + q) * 2048 + lane;
            const int klim = tqb + q + 1;
#pragma unroll
            for (int i = 0; i < 32; ++i) s[i] = __uint_as_float(s0[64 * i]);
            asm volatile("" ::: "memory");
            unsigned nq = 0xffffffffu;
            if (t0 >= 256) nq = select_fused(s, klim, s0, scr, lane, lst0 + q * 256);
            if (nq == 0xffffffffu) {
#pragma unroll
                for (int i = 0; i < 32; ++i) s[i] = (64 * i + lane < klim) ? s[i] : -INFINITY;
                float Ts = -3.0e38f; unsigned tieneed = 4096u;
                if (t0 >= 256) select_bisect(s, Ts, tieneed);
                if (tieneed >= 4096u) nq = select_emit_scan(s, kmax, Ts, lst0 + q * 256, (LAS unsigned short*)(scr + 1536), lane);
                else nq = select_emit(s, kmax, Ts, tieneed, lst0 + q * 256, (LAS unsigned short*)(scr + 1536), lane);
            }
            {
                LAS unsigned short* le = lst0 + q * 256 + 4 * lane;
                asm volatile("" ::: "memory");
                const u32x2 e = *(const LAS u32x2*)le;
                const int tq_ = klim - 1;
                const unsigned k0 = e.x & 0xffffu, k1 = e.x >> 16, k2 = e.y & 0xffffu, k3 = e.y >> 16;
                const unsigned b0 = bkt[tq_ - (int)k0], b1 = bkt[tq_ - (int)k1], b2 = bkt[tq_ - (int)k2], b3 = bkt[tq_ - (int)k3];
                u32x2 o; o.x = e.x | (b0 << 11) | (b1 << 27); o.y = e.y | (b2 << 11) | (b3 << 27);
                *(LAS u32x2*)le = o;
                asm volatile("" ::: "memory");
            }
            if (q == 0) { n0 = nq; cx.ng0 = ((int)nq + 31) >> 5; cx.nu = cx.ng0;
#ifdef EARLY_GATHER
                att_prefetch(S0, cx, 0); att_prefetch(S1, cx, 1); att_prefetch(S2, cx, 2);
#endif
            }
            else n1 = nq;
        }
    }
    __builtin_amdgcn_s_setprio(3);
    for (int repa = 0; repa < REP_ATT; ++repa) {
        const int lane3 = lane;
        const int g = lane3 >> 4, hc = lane3 & 15;
        LAS bf16* Ks = (LAS bf16*)(lds + wave * 16384);
        LAS bf16* Vs = Ks + 32 * KS_LD;
        LAS bf16x8* Qs = (LAS bf16x8*)(Vs + 32 * VS_LD);
        LAS bf16* Gs = (LAS bf16*)(Qs + 256);
        const float SC = 0.125f * LOG2E;
        const int ng0 = cx.ng0, ng1 = ((int)n1 + 31) >> 5, nu = ng0 + ng1;
        cx.nu = nu;
#pragma unroll
        for (int qq = 0; qq < 2; ++qq) {
#pragma unroll
            for (int ks = 0; ks < 2; ++ks) Qs[(qq * 2 + ks) * 64 + lane3] = qv[qq][ks];
            *(LAS v4u*)(Gs + qq * 512 + 8 * lane3) = gav[qq];
        }
#ifdef EARLY_GATHER
        if (0 >= ng0) att_prefetch(S0, cx, 0);
        if (1 >= ng0) att_prefetch(S1, cx, 1);
        if (2 >= ng0) att_prefetch(S2, cx, 2);
#else
        att_prefetch(S0, cx, 0); att_prefetch(S1, cx, 1); att_prefetch(S2, cx, 2);
#endif
        f32x4 O[4];
#pragma unroll
        for (int nt = 0; nt < 4; ++nt) O[nt] = (f32x4){0.f, 0.f, 0.f, 0.f};
        float lsum = 0.f;
        att_stage(S0, cx, Ks, Vs);
#define ATT_STEP(S, N, uu, PF) do { const int u_ = (uu); \
            const int qi = (u_ >= ng0) ? 1 : 0, grp = u_ - (qi ? ng0 : 0); \
            if (u_ + 1 == ng0) { qreg[0] = Qs[128 + lane3]; qreg[1] = Qs[128 + 64 + lane3]; }            \
            att_step<PF>(S, N, cx, u_, grp, qi ? (int)n1 : (int)n0, qreg, Ks, Vs, SC, O, lsum, C0, C1); \
            if (grp == (qi ? ng1 : ng0) - 1) att_finish(A, rb + tqb + qi, Gs + qi * 512, (LAS float*)Qs, g, hc, O, lsum); } while (0)
        bf16x8 qreg[2]; qreg[0] = Qs[lane3]; qreg[1] = Qs[64 + lane3];
        f32x4 C0 = (f32x4){0.f, 0.f, 0.f, 0.f}, C1 = (f32x4){0.f, 0.f, 0.f, 0.f};
        {
            asm volatile("" ::: "memory");
            bf16x8 a0[2], a1[2];
#pragma unroll
            for (int ks = 0; ks < 2; ++ks) { a0[ks] = *(const LAS bf16x8*)(Ks + hc * KS_LD + (g + 4 * ks) * 8); a1[ks] = *(const LAS bf16x8*)(Ks + (16 + hc) * KS_LD + (g + 4 * ks) * 8); }
            C0 = __builtin_amdgcn_mfma_f32_16x16x32_bf16(a0[0], qreg[0], C0, 0, 0, 0); C1 = __builtin_amdgcn_mfma_f32_16x16x32_bf16(a1[0], qreg[0], C1, 0, 0, 0);
            C0 = __builtin_amdgcn_mfma_f32_16x16x32_bf16(a0[1], qreg[1], C0, 0, 0, 0); C1 = __builtin_amdgcn_mfma_f32_16x16x32_bf16(a1[1], qreg[1], C1, 0, 0, 0);
            asm volatile("" ::: "memory");
        }
        int u = 0;
        for (; u + 3 <= nu; u += 3) { ATT_STEP(S0, S1, u, true); ATT_STEP(S1, S2, u + 1, true); ATT_STEP(S2, S0, u + 2, true); }
        if (u < nu) { ATT_STEP(S0, S1, u, false); if (u + 1 < nu) ATT_STEP(S1, S2, u + 1, false); }
#undef ATT_STEP
    }
    __builtin_amdgcn_s_setprio(0);
    sweep_load(P, A, b_next, t0_next, wg, lane_in);
    grp_barrier(gctr, ggen, lane_in);
}

__device__ __forceinline__ void p2_mixers(Frame& F0, int l) {
    Frame F = F0; { int t = F.tid; asm volatile("" : "+v"(t)); F.tid = t; F.lane = t & 63; }
    unsigned char* ws = F.ws;
    LAS unsigned char* bkt = F.lds + L_BKT; LAS float* biasb = (LAS float*)(F.lds + L_BIASB); LAS float* mfx = (LAS float*)(F.lds + L_MFIX);
    if (F.wave == 0) {
        const float gq = fabsf(F.q_norm_g[l * 64 + F.lane]), gk = fabsf(F.k_norm_g[l * 64 + F.lane]);
        float bm = 0.f;
#pragma unroll
        for (int i = 0; i < 4; ++i) bm = fmaxf(bm, fabsf(F.rel_bias[F.lane * 4 + i]));
        const float gqm = wave_max(gq), gkm = wave_max(gk), bmm = wave_max(bm);
        if (F.lane == 0) mfx[0] = 8.0f * gqm * gkm + bmm;
    }
    for (int d = F.tid; d < 2048; d += NWAVES * 64) {
        int bk;
        if (d < 16) bk = d; else { const float v = logf((float)d / 16.0f) / logf(8.0f) * 16.0f; bk = 16 + (int)v; bk = bk > 31 ? 31 : bk; }
        bkt[d] = (unsigned char)bk;
    }
    const float relb = (F.tid < 256) ? F.rel_bias[F.tid] : 0.f;
    for (int reps = 0; reps < REP_SGU; ++reps)
    for (int chn = F.vcu; chn < 256; chn += F.G) {
#ifndef NO_SGU
        sgu_chunk(F, chn * 128, (const bf16*)(ws + WS_VB), (const bf16*)(ws + WS_U), (const bf16*)(ws + WS_GB), (const bf16*)(ws + WS_WSP) + (size_t)l * 4 * 128 * 128,
                  F.b_spatial + l * 512, F.sgu_ln_g + l * 512, F.sgu_ln_b + l * 512, (bf16*)(ws + WS_YB));
#endif
    }
    const AttnT A{ws};
    __syncthreads();
    if (F.tid < 256) biasb[F.tid] = (relb - mfx[0]) * LOG2E;
    LAS unsigned* gctr = (LAS unsigned*)(F.lds + L_GBAR) + 16 * (F.wave / GW);
    if (F.tid < 64) ((LAS unsigned*)(F.lds + L_GBAR))[F.tid] = 0u;
    __syncthreads();
    unsigned ggen = 0u;
    for (int v = F.vcu; v < 256; v += F.G) {
        const int b = v >> 4, j = v & 15, grp = F.wave / GW, wg = F.wave % GW;
#define ITEM_T0(ii) ({ const int i_ = (grp & 1) ? 7 - (ii) : (ii); const int i2_ = (grp & 2) ? (i_ ^ 1) : i_; 16 * ((i2_ & 1) ? (32 * (i2_ >> 1) + 31 - j) : (32 * (i2_ >> 1) + j)) + GQ * grp; })
        SweepOps P;
        sweep_load(P, A, b, ITEM_T0(0), wg, F.lane);
        for (int i = 0; i < 8; ++i) {
            const int t0 = ITEM_T0(i), t0n = (i < 7) ? ITEM_T0(i + 1) : t0;
            attn_item16(A, b, t0, b, t0n, P, F.lds, F.wave, F.lane, gctr, ggen);
        }
#undef ITEM_T0
    }
    __syncthreads();
}

#ifndef REP_P0
#define REP_P0 1
#endif
#ifndef REP_P1
#define REP_P1 1
#endif
#ifndef REP_P2
#define REP_P2 1
#endif
#ifndef REP_P3
#define REP_P3 1
#endif
struct Args { const float* in[12]; float* out; unsigned char* ws; };
__global__ void __launch_bounds__(NWAVES * 64, 2) fwd_mega(Args args) {
    extern __shared__ __attribute__((aligned(16))) unsigned char lds[];
    Frame F;
    F.lds = (LAS unsigned char*)lds;
    F.tid = threadIdx.x; F.lane = F.tid & 63; F.wave = __builtin_amdgcn_readfirstlane(F.tid >> 6);
    F.G = gridDim.x; { const int bx = blockIdx.x; F.vcu = (F.G % 8 == 0) ? (bx % 8) * (F.G / 8) + bx / 8 : bx; }
    F.x = args.in[0]; F.norm_g = args.in[1]; F.w_in = args.in[2]; F.q_norm_g = args.in[3]; F.k_norm_g = args.in[4]; F.rel_bias = args.in[5];
    F.sgu_ln_g = args.in[6]; F.sgu_ln_b = args.in[7]; F.w_spatial = args.in[8]; F.b_spatial = args.in[9]; F.w_branch = args.in[10]; F.w_out = args.in[11];
    F.out = args.out; F.ws = args.ws;
    unsigned char* ws = args.ws;
    for (int u = F.tid; u < (LDS_BYTES - LDSCTL_OFF) / 4; u += NWAVES * 64) ((LAS unsigned*)(F.lds + LDSCTL_OFF))[u] = 0u;
    __syncthreads();
    volatile LAS unsigned* MISC = (volatile LAS unsigned*)(F.lds + MISC_OFF);
    XcdBarrier bar = xcd_barrier_post((unsigned*)(ws + WS_CTL) + CW_BAR, MISC + 8);
#if defined(BAR2)
#define GRID_BAR() do { xcd_barrier(bar); xcd_barrier(bar); } while (0)
#else
#define GRID_BAR() xcd_barrier(bar)
#endif

#if !defined(PHM) || (PHM & 1)
    for (int rep0 = 0; rep0 < REP_P0; ++rep0) p0_prologue(F);
#endif
    GRID_BAR();
    for (int l = 0; l < 2; ++l) {
#if !defined(PHM) || (PHM & 2)
        for (int rep1 = 0; rep1 < REP_P1; ++rep1)
        {
            pg8::Gemm g{(const pg8::bf16_t*)(ws + WS_XN), (const pg8::bf16_t*)(ws + WS_WIN + l * WIN_LAYER), M, NIN, DM, nullptr, nullptr};
            pg8::StaticOrder S; S.init(M, NIN, F.G, (int)blockIdx.x, WGM_P1);
            pg8::EpiIn E{ws, F.q_norm_g + l * 64, F.k_norm_g + l * 64, WS_Q, WS_K, WS_QI, WS_WI};
            pg8::gemm_phase<pg8::EpiIn, pg8::StaticOrder, true, true>(F.lds + RING_OFF, g, S, E);
        }
#endif
        GRID_BAR();
#if !defined(PHM) || (PHM & 4)
        for (int rep2 = 0; rep2 < REP_P2; ++rep2) { p2_mixers(F, l); if (REP_P2 > 1) __syncthreads(); }
#endif
        GRID_BAR();
#if !defined(PHM) || (PHM & 8)
        for (int rep3 = 0; rep3 < REP_P3; ++rep3)
        {
            pg8::TwoSegOrder S; S.init(M, DM, F.G, (int)blockIdx.x, WGM_P3);
            pg8::Gemm g{(const pg8::bf16_t*)(ws + WS_YA), (const pg8::bf16_t*)(ws + WS_WBR + (size_t)(l * 2 + 0) * MiB), M, DM, 512,
                        (const pg8::bf16_t*)(ws + WS_YB), (const pg8::bf16_t*)(ws + WS_WBR + (size_t)(l * 2 + 1) * MiB)};
            pg8::EpiMerge E{(const pg8::bf16_t*)(ws + WS_MA), (const pg8::bf16_t*)(ws + WS_MB), (pg8::bf16_t*)(ws + WS_T)};
            pg8::gemm_phase<pg8::EpiMerge, pg8::TwoSegOrder, true, true>(F.lds + RING_OFF, g, S, E);
        }
#endif
        GRID_BAR();
#if !defined(PHM) || (PHM & 16)
        {
            pg8::Gemm g{(const pg8::bf16_t*)(ws + WS_T), (const pg8::bf16_t*)(ws + WS_WOUT + (size_t)l * 2 * MiB), M, DM, DM, nullptr, nullptr};
            pg8::StaticOrder S; S.init(M, DM, F.G, (int)blockIdx.x, WGM_P4);
            pg8::EpiOut E{F.x, (const pg8::bf16_t*)(ws + WS_X1B), F.out, (pg8::bf16_t*)(ws + WS_X1B), l};
            pg8::gemm_phase<pg8::EpiOut, pg8::StaticOrder, true, true>(F.lds + RING_OFF, g, S, E);
        }
#endif
#if !defined(PHM) || (PHM & 32)
        if (l == 0) { GRID_BAR(); p5_renorm(F, (const bf16*)(ws + WS_X1B), F.norm_g + DM); GRID_BAR(); }
#endif
    }
#undef GRID_BAR
}

extern "C" void kernel_launch(void* const* d_in, const int* in_sizes, int n_in, void* d_out, int out_size, void* d_ws, size_t ws_size, hipStream_t stream) {
    static int grid = 0;
    if (grid == 0) {
        if (n_in != 12 || in_sizes[0] != M * DM || out_size != M * DM || ws_size < WS_END) { fprintf(stderr, "kernel_launch: unexpected shapes: n_in %d in0 %d out %d ws %zu (need %zu)\n", n_in, n_in > 0 ? in_sizes[0] : -1, out_size, ws_size, (size_t)WS_END); grid = -1; return; }
        int dev = 0, cus = 0, per_cu = 0;
        if (hipGetDevice(&dev) != hipSuccess || hipDeviceGetAttribute(&cus, hipDeviceAttributeMultiprocessorCount, dev) != hipSuccess) { fprintf(stderr, "kernel_launch: device query failed\n"); grid = -1; return; }
        if (hipFuncSetAttribute((const void*)fwd_mega, hipFuncAttributeMaxDynamicSharedMemorySize, LDS_BYTES) != hipSuccess) { fprintf(stderr, "kernel_launch: hipFuncSetAttribute failed\n"); grid = -1; return; }
        if (hipOccupancyMaxActiveBlocksPerMultiprocessor(&per_cu, (const void*)fwd_mega, NWAVES * 64, LDS_BYTES) != hipSuccess || per_cu < 1) { fprintf(stderr, "kernel_launch: occupancy query reports %d workgroups per CU\n", per_cu); }
        (void)hipGetLastError();
        grid = cus;
        if (grid != 256) fprintf(stderr, "kernel_launch: note: %d CUs\n", grid);
    }
    if (grid < 0) return;
    if (hipMemsetAsync((char*)d_ws + WS_CTL, 0, CTL_ZERO_BYTES, stream) != hipSuccess) { fprintf(stderr, "kernel_launch: memset failed\n"); return; }
    Args a{};
    for (int i = 0; i < 12; ++i) a.in[i] = (const float*)d_in[i];
    a.out = (float*)d_out; a.ws = (unsigned char*)d_ws;
    hipLaunchKernelGGL(fwd_mega, dim3(grid), dim3(NWAVES * 64), LDS_BYTES, stream, a);
    const hipError_t le = hipPeekAtLastError();
    if (le != hipSuccess) fprintf(stderr, "kernel_launch: launch failed: %s\n", hipGetErrorName(le));
}
```
